# Optimizing an MI355X kernel written in HIP

```python
import math
import jax
import jax.numpy as jnp
from jax import lax
import numpy as np

D_MODEL = 1024
BATCH = 8
SEQ = 2048
DEPTH = 2

GROUP_WIDTH = D_MODEL // 4
D_MIX = 4 * GROUP_WIDTH

GDN_HEADS = 4
GDN_DK = 64
GDN_DV = GROUP_WIDTH // GDN_HEADS
GDN_CONV = 4
GDN_CHUNK = 64
GDN_QKV = GDN_HEADS * (2 * GDN_DK + GDN_DV)

MLA_HEADS = 4
MLA_NOPE = 64
MLA_ROPE = 32
MLA_V = GROUP_WIDTH // MLA_HEADS
MLA_Q_RANK = 192
MLA_KV_RANK = 128
ROPE_BASE = 10000.0
ATTN_BLOCK = 128

HGRN_HEADS = 4
HGRN_DK = 64
HGRN_DV = GROUP_WIDTH // HGRN_HEADS
HGRN_CHUNK = 16

DSA_HEADS = 4
DSA_DH = GROUP_WIDTH // DSA_HEADS
DSA_BRANCHES = ((128, 1), (512, 4), (2048, 16))
DSA_BLOCK = 128

D_FF = 4 * D_MODEL
DEEPNORM_ALPHA = (2 * DEPTH) ** 0.25
DEEPNORM_BETA = (8 * DEPTH) ** -0.25
NORM_EPS = 1e-6
MASK_VALUE = -1e30

IN_SIZES = (
    GDN_QKV, GDN_HEADS, GDN_HEADS, GDN_HEADS * GDN_DV,
    MLA_Q_RANK, MLA_KV_RANK, MLA_ROPE,
    HGRN_HEADS * HGRN_DK, HGRN_HEADS * HGRN_DK,
    HGRN_HEADS * HGRN_DV, HGRN_HEADS * HGRN_DV,
    3 * DSA_HEADS * DSA_DH,
)
D_IN = sum(IN_SIZES)

kernel_name = 'hybrid_parallel_heads_deepnorm'


def _layer_norm(x, g, b):
    xf = x.astype(jnp.float32)
    mu = jnp.mean(xf, axis=-1, keepdims=True)
    var = jnp.mean(jnp.square(xf - mu), axis=-1, keepdims=True)
    return ((xf - mu) * lax.rsqrt(var + NORM_EPS) * g + b).astype(x.dtype)


def _rms_norm(x, g):
    xf = x.astype(jnp.float32)
    return (xf * lax.rsqrt(jnp.mean(xf * xf, axis=-1, keepdims=True) + NORM_EPS) * g).astype(x.dtype)


def _l2norm(x):
    return x * lax.rsqrt(jnp.sum(x * x, axis=-1, keepdims=True) + NORM_EPS)


def _masked_exp(mask, log_ratio):
    return jnp.where(mask, jnp.exp(jnp.where(mask, log_ratio, 0.0)), 0.0)


def _rope(x, pos):
    half = x.shape[-1] // 2
    inv_freq = ROPE_BASE ** (-jnp.arange(half, dtype=jnp.float32) / half)
    ang = pos[:, None] * inv_freq[None, :]
    cos = jnp.cos(ang)[None, :, None, :].astype(x.dtype)
    sin = jnp.sin(ang)[None, :, None, :].astype(x.dtype)
    x1, x2 = x[..., :half], x[..., half:]
    return jnp.concatenate([x1 * cos - x2 * sin, x1 * sin + x2 * cos], axis=-1)


def _causal_depthwise_conv_silu(x, w):
    k_width, ch = w.shape
    y = lax.conv_general_dilated(
        x, w[:, None, :].astype(x.dtype), window_strides=(1,), padding=((k_width - 1, 0),),
        dimension_numbers=('NWC', 'WIO', 'NWC'), feature_group_count=ch)
    return jax.nn.silu(y)


def _gated_delta_rule(q, k, v, g, beta):
    b_, s_, h, dk = q.shape
    dv = v.shape[-1]
    c = GDN_CHUNK
    n = s_ // c
    q = q.reshape(b_, n, c, h, dk)
    k = k.reshape(b_, n, c, h, dk)
    v = v.reshape(b_, n, c, h, dv)
    beta = beta.reshape(b_, n, c, h)
    g = jnp.cumsum(g.reshape(b_, n, c, h), axis=2)
    causal = jnp.tril(jnp.ones((c, c), bool))
    strict = jnp.tril(jnp.ones((c, c), bool), -1)
    g_h = jnp.moveaxis(g, 2, 3)
    decay = _masked_exp(causal, g_h[..., :, None] - g_h[..., None, :])
    k_beta = k * beta[..., None]
    lower = jnp.where(strict, jnp.einsum('bnihd,bnjhd->bnhij', k_beta, k) * decay, 0.0)
    eye = jnp.eye(c, dtype=q.dtype)
    t_inv = lax.linalg.triangular_solve(lower + eye, jnp.broadcast_to(eye, lower.shape),
                                        left_side=True, lower=True, unit_diagonal=True)
    u = jnp.einsum('bnhij,bnjhd->bnihd', t_inv, v * beta[..., None])
    w = jnp.einsum('bnhij,bnjhd->bnihd', t_inv, k_beta * jnp.exp(g)[..., None])
    qk = jnp.einsum('bnihd,bnjhd->bnhij', q, k) * decay
    q_dec = q * jnp.exp(g)[..., None]
    g_last = g[:, :, -1]
    k_dec = k * jnp.exp(g_last[:, :, None] - g)[..., None]

    def step(state, xs):
        u_n, w_n, q_n, k_n, qk_n, gl_n = xs
        v_new = u_n - jnp.einsum('bchk,bhkv->bchv', w_n, state)
        o_n = jnp.einsum('bchk,bhkv->bchv', q_n, state) + jnp.einsum('bhij,bjhv->bihv', qk_n, v_new)
        state = state * jnp.exp(gl_n)[..., None, None] + jnp.einsum('bchk,bchv->bhkv', k_n, v_new)
        return state, o_n

    xs = tuple(jnp.moveaxis(t, 1, 0) for t in (u, w, q_dec, k_dec, qk, g_last))
    state0 = jnp.zeros((b_, h, dk, dv), q.dtype)
    _, o = lax.scan(step, state0, xs)
    return jnp.moveaxis(o, 0, 1).reshape(b_, s_, h, dv)


def _gated_deltanet(qkv, a, b, z, conv_w, a_log, dt_bias, norm_g):
    b_, s_, _ = qkv.shape
    qkv = _causal_depthwise_conv_silu(qkv, conv_w).astype(jnp.float32)
    q, k, v = jnp.split(qkv, [GDN_HEADS * GDN_DK, 2 * GDN_HEADS * GDN_DK], axis=-1)
    q = _l2norm(q.reshape(b_, s_, GDN_HEADS, GDN_DK)) * (GDN_DK ** -0.5)
    k = _l2norm(k.reshape(b_, s_, GDN_HEADS, GDN_DK))
    v = v.reshape(b_, s_, GDN_HEADS, GDN_DV)
    beta = jax.nn.sigmoid(b.astype(jnp.float32))
    g = -jnp.exp(a_log.astype(jnp.float32)) * jax.nn.softplus(a.astype(jnp.float32) + dt_bias.astype(jnp.float32))
    o = _gated_delta_rule(q, k, v, g, beta)
    o = _rms_norm(o, norm_g) * jax.nn.silu(z.reshape(b_, s_, GDN_HEADS, GDN_DV).astype(jnp.float32))
    return o.reshape(b_, s_, GDN_HEADS * GDN_DV).astype(z.dtype)


def _causal_block_attention(q, k, v):
    b_, s_, h, dqk = q.shape
    nblk = s_ // ATTN_BLOCK
    scale = dqk ** -0.5
    q_blocks = jnp.moveaxis(q.reshape(b_, nblk, ATTN_BLOCK, h, dqk), 1, 0)
    k_pos = jnp.arange(s_)

    def attend(args):
        qb, n = args
        s = jnp.einsum('bqhd,bkhd->bhqk', qb, k).astype(jnp.float32) * scale
        q_pos = n * ATTN_BLOCK + jnp.arange(ATTN_BLOCK)
        s = jnp.where(k_pos[None, :] <= q_pos[:, None], s, MASK_VALUE)
        p = jax.nn.softmax(s, axis=-1)
        return jnp.einsum('bhqk,bkhd->bqhd', p.astype(v.dtype), v)

    o = lax.map(attend, (q_blocks, jnp.arange(nblk)))
    return jnp.moveaxis(o, 0, 1).reshape(b_, s_, h, v.shape[-1])


def _mla(c_q, c_kv, k_rope, q_norm_g, kv_norm_g, w_uq, w_ukv, pos):
    b_, s_, _ = c_q.shape
    q = (_rms_norm(c_q, q_norm_g) @ w_uq).reshape(b_, s_, MLA_HEADS, MLA_NOPE + MLA_ROPE)
    kv = (_rms_norm(c_kv, kv_norm_g) @ w_ukv).reshape(b_, s_, MLA_HEADS, MLA_NOPE + MLA_V)
    q = jnp.concatenate([q[..., :MLA_NOPE], _rope(q[..., MLA_NOPE:], pos)], axis=-1)
    k_r = jnp.broadcast_to(_rope(k_rope[:, :, None, :], pos), (b_, s_, MLA_HEADS, MLA_ROPE))
    k = jnp.concatenate([kv[..., :MLA_NOPE], k_r], axis=-1)
    v = kv[..., MLA_NOPE:]
    o = _causal_block_attention(q, k, v)
    return o.reshape(b_, s_, MLA_HEADS * MLA_V)


def _gla_chunked(q, k, v, log_f):
    b_, s_, h, dk = q.shape
    dv = v.shape[-1]
    c = HGRN_CHUNK
    n = s_ // c
    q = q.reshape(b_, n, c, h, dk)
    k = k.reshape(b_, n, c, h, dk)
    v = v.reshape(b_, n, c, h, dv)
    cum = jnp.cumsum(log_f.reshape(b_, n, c, h, dk), axis=2)
    causal = jnp.tril(jnp.ones((c, c), bool))[:, :, None, None]
    decay = _masked_exp(causal, cum[:, :, :, None] - cum[:, :, None, :])
    scores = jnp.sum(q[:, :, :, None] * k[:, :, None, :] * decay, axis=-1)
    o_intra = jnp.einsum('bntsh,bnshv->bnthv', scores, v)
    cum_last = cum[:, :, -1]
    k_dec = k * jnp.exp(cum_last[:, :, None] - cum)

    def step(state, xs):
        k_n, v_n, gl_n = xs
        new = state * jnp.exp(gl_n)[..., None] + jnp.einsum('bchk,bchv->bhkv', k_n, v_n)
        return new, state

    xs = tuple(jnp.moveaxis(t, 1, 0) for t in (k_dec, v, cum_last))
    _, s_prev = lax.scan(step, jnp.zeros((b_, h, dk, dv), q.dtype), xs)
    o_inter = jnp.einsum('bnchk,nbhkv->bnchv', q * jnp.exp(cum), s_prev)
    return (o_intra + o_inter).reshape(b_, s_, h, dv)


def _hgrn2(q, f, i, g, lb, norm_g):
    b_, s_, _ = q.shape
    qf = q.reshape(b_, s_, HGRN_HEADS, HGRN_DK).astype(jnp.float32)
    fl = f.reshape(b_, s_, HGRN_HEADS, HGRN_DK).astype(jnp.float32)
    lb = lb.reshape(HGRN_HEADS, HGRN_DK)
    log_f = jnp.log(lb + (1.0 - lb) * jax.nn.sigmoid(fl))
    k = (1.0 - lb) * jax.nn.sigmoid(-fl)
    v = i.reshape(b_, s_, HGRN_HEADS, HGRN_DV).astype(jnp.float32)
    o = _gla_chunked(qf, k, v, log_f)
    o = _rms_norm(o, norm_g) * jax.nn.silu(g.reshape(b_, s_, HGRN_HEADS, HGRN_DV).astype(jnp.float32))
    return o.reshape(b_, s_, HGRN_HEADS * HGRN_DV).astype(q.dtype)


def _alibi_slopes(n):
    return jnp.asarray([2.0 ** (-8.0 * (j + 1) / n) for j in range(n)], dtype=jnp.float32)


def _dilated_branch(q, k, v, slopes, window, dilation):
    b_, s_, h, dh = q.shape
    length = s_ // dilation
    steps_max = window // dilation
    bb = b_ * dilation

    def sub(t):
        return jnp.moveaxis(t.reshape(b_, length, dilation, h, dh), 2, 1).reshape(bb, length, h, dh)

    nblk = -(-length // DSA_BLOCK)
    lp = nblk * DSA_BLOCK
    pad = ((0, 0), (0, lp - length), (0, 0), (0, 0))
    qs, ks, vs = (jnp.pad(sub(t), pad).reshape(bb, nblk, DSA_BLOCK, h, dh) for t in (q, k, v))
    k_cat = jnp.concatenate([jnp.concatenate([jnp.zeros_like(ks[:, :1]), ks[:, :-1]], axis=1), ks], axis=2)
    v_cat = jnp.concatenate([jnp.concatenate([jnp.zeros_like(vs[:, :1]), vs[:, :-1]], axis=1), vs], axis=2)
    qi = jnp.arange(DSA_BLOCK)[:, None]
    ki = jnp.arange(2 * DSA_BLOCK)[None, :]
    steps = DSA_BLOCK + qi - ki
    blk = jnp.arange(nblk)[:, None, None]
    valid = (steps >= 0) & (steps <= steps_max) & (blk * DSA_BLOCK + ki - DSA_BLOCK >= 0)
    alibi = -slopes[:, None, None] * (steps * dilation).astype(jnp.float32)
    s = jnp.einsum('bnqhd,bnkhd->bnhqk', qs, k_cat).astype(jnp.float32) * (dh ** -0.5) + alibi[None, None]
    s = jnp.where(valid[None, :, None], s, MASK_VALUE)
    lse = jax.nn.logsumexp(s, axis=-1)
    p = jnp.exp(s - lse[..., None])
    o = jnp.einsum('bnhqk,bnkhd->bnqhd', p.astype(v.dtype), v_cat)
    o = o.reshape(bb, lp, h, dh)[:, :length].reshape(b_, dilation, length, h, dh)
    o = jnp.moveaxis(o, 1, 2).reshape(b_, s_, h, dh)
    lse = jnp.swapaxes(lse, 2, 3).reshape(bb, lp, h)[:, :length].reshape(b_, dilation, length, h)
    lse = jnp.moveaxis(lse, 1, 2).reshape(b_, s_, h)
    return o, lse


def _dilated_attention(qkv):
    b_, s_, _ = qkv.shape
    q, k, v = (t.reshape(b_, s_, DSA_HEADS, DSA_DH) for t in jnp.split(qkv, 3, axis=-1))
    slopes = _alibi_slopes(DSA_HEADS)
    outs, lses = [], []
    for window, dilation in DSA_BRANCHES:
        o, lse = _dilated_branch(q, k, v, slopes, window, dilation)
        outs.append(o)
        lses.append(lse)
    weights = jax.nn.softmax(jnp.stack(lses, axis=0), axis=0)
    o = jnp.sum(weights[..., None] * jnp.stack(outs, axis=0).astype(jnp.float32), axis=0)
    return o.reshape(b_, s_, DSA_HEADS * DSA_DH).astype(qkv.dtype)


def _sq_relu_mlp(x, w1, w2):
    return jnp.square(jax.nn.relu(x @ w1)) @ w2


def setup_inputs(seed: int = 0) -> dict:
    key = jax.random.key(seed)
    ks = jax.random.split(key, 20)
    f32 = jnp.float32

    def normal(k, shape, scale):
        return jax.random.normal(k, shape, f32) * scale

    def gain(k, shape):
        return 1.0 + normal(k, shape, 0.02)

    dt = jnp.exp(jax.random.uniform(ks[4], (DEPTH, GDN_HEADS), f32, math.log(1e-3), math.log(1e-1)))
    return {
        'x': normal(ks[0], (BATCH, SEQ, D_MODEL), 1.0),
        'w_in': normal(ks[1], (DEPTH, D_MODEL, D_IN), D_MODEL ** -0.5),
        'gdn_conv_w': normal(ks[2], (DEPTH, GDN_CONV, GDN_QKV), GDN_CONV ** -0.5),
        'gdn_a_log': jnp.log(jax.random.uniform(ks[3], (DEPTH, GDN_HEADS), f32, 1.0, 16.0)),
        'gdn_dt_bias': dt + jnp.log(-jnp.expm1(-dt)),
        'gdn_norm_g': gain(ks[5], (DEPTH, GDN_DV)),
        'mla_q_norm_g': gain(ks[6], (DEPTH, MLA_Q_RANK)),
        'mla_kv_norm_g': gain(ks[7], (DEPTH, MLA_KV_RANK)),
        'mla_w_uq': normal(ks[8], (DEPTH, MLA_Q_RANK, MLA_HEADS * (MLA_NOPE + MLA_ROPE)), MLA_Q_RANK ** -0.5),
        'mla_w_ukv': normal(ks[9], (DEPTH, MLA_KV_RANK, MLA_HEADS * (MLA_NOPE + MLA_V)), MLA_KV_RANK ** -0.5),
        'hgrn_lb_logits': normal(ks[10], (DEPTH, HGRN_HEADS * HGRN_DK), 0.5),
        'hgrn_norm_g': gain(ks[11], (DEPTH, HGRN_DV)),
        'w_out': normal(ks[12], (DEPTH, D_MIX, D_MODEL), D_MIX ** -0.5 * DEEPNORM_BETA),
        'ln1_g': gain(ks[13], (DEPTH, D_MODEL)),
        'ln1_b': normal(ks[14], (DEPTH, D_MODEL), 0.02),
        'w_ff1': normal(ks[15], (DEPTH, D_MODEL, D_FF), D_MODEL ** -0.5),
        'w_ff2': normal(ks[16], (DEPTH, D_FF, D_MODEL), D_FF ** -0.5 * DEEPNORM_BETA),
        'ln2_g': gain(ks[17], (DEPTH, D_MODEL)),
        'ln2_b': normal(ks[18], (DEPTH, D_MODEL), 0.02),
    }


def reference(x, w_in, gdn_conv_w, gdn_a_log, gdn_dt_bias, gdn_norm_g, mla_q_norm_g, mla_kv_norm_g,
              mla_w_uq, mla_w_ukv, hgrn_lb_logits, hgrn_norm_g, w_out, ln1_g, ln1_b, w_ff1, w_ff2,
              ln2_g, ln2_b):
    pos = jnp.arange(x.shape[1], dtype=jnp.float32)
    p_lb = jax.nn.softmax(hgrn_lb_logits.astype(jnp.float32), axis=0)
    lower_bounds = jnp.cumsum(p_lb, axis=0) - p_lb[:1]
    split_points = np.cumsum(IN_SIZES)[:-1].tolist()
    for l in range(DEPTH):
        h = x @ w_in[l]
        (a_qkv, a_a, a_b, a_z, b_cq, b_ckv, b_kr,
         c_q, c_f, c_i, c_g, d_qkv) = jnp.split(h, split_points, axis=-1)
        o_a = _gated_deltanet(a_qkv, a_a, a_b, a_z, gdn_conv_w[l], gdn_a_log[l], gdn_dt_bias[l], gdn_norm_g[l])
        o_b = _mla(b_cq, b_ckv, b_kr, mla_q_norm_g[l], mla_kv_norm_g[l], mla_w_uq[l], mla_w_ukv[l], pos)
        o_c = _hgrn2(c_q, c_f, c_i, c_g, lower_bounds[l], hgrn_norm_g[l])
        o_d = _dilated_attention(d_qkv)
        mixed = jnp.concatenate([o_a, o_b.astype(x.dtype), o_c, o_d], axis=-1) @ w_out[l]
        x = _layer_norm(DEEPNORM_ALPHA * x + mixed, ln1_g[l], ln1_b[l])
        x = _layer_norm(DEEPNORM_ALPHA * x + _sq_relu_mlp(x, w_ff1[l], w_ff2[l]), ln2_g[l], ln2_b[l])
    return x
```

```cpp
#include <hip/hip_runtime.h>
#include <hip/hip_cooperative_groups.h>
#include <cstdio>
#include <cstdint>
namespace cg = cooperative_groups;
namespace pg8 {
#define PG8_LAS __attribute__((address_space(3)))
typedef unsigned short bf16_t;
typedef short bf16x8 __attribute__((ext_vector_type(8)));
typedef float f32x4 __attribute__((ext_vector_type(4)));
typedef unsigned u32x4 __attribute__((ext_vector_type(4)));
constexpr int BM = 256, BK = 64, HALF = 128, HTB = HALF * BK * 2  , STAGE_BYTES = 8 * HTB, NXCD = 8, WGM = 8;

__host__ __device__ __forceinline__ int lds_byte(int r, int c) { const int st = (r >> 4) * 2 + (c >> 5), rr = r & 15, cc = c & 31, ob = rr * 64 + cc * 2; return st * 1024 + (ob ^ (((ob >> 9) & 1) << 5)); }
__host__ __device__ __forceinline__ void stage_rc(int b, int& R, int& C) { const int st = b / 1024, sb = b % 1024, swz = sb ^ (((sb >> 9) & 1) << 5); R = (st >> 1) * 16 + swz / 64; C = (st & 1) * 32 + (swz % 64) / 2; }
__host__ __device__ __forceinline__ int perm32(int rho) { const int n = rho >> 4, i = rho & 15; return 8 * (i >> 2) + 4 * n + (i & 3); }

struct Unit { int pm, pn; };
struct Gemm { const bf16_t* A; const bf16_t* Bt; int M, N, K; };

struct StaticOrder {
    int nM, nN, nwg, G, c;
    __host__ __device__ void init(int M, int N, int G_, int c_) { nM = M / BM; nN = N / BM; nwg = nM * nN; G = G_; c = c_; }
    __host__ __device__ bool next(int i, Unit& u) const {
        const long L = (long)i * G + c; if (L >= nwg) return false;
        int wgid = (int)L; { const int q = nwg / NXCD, r = nwg % NXCD, xcd = wgid % NXCD, off = wgid / NXCD; wgid = (xcd < r ? xcd * (q + 1) : r * (q + 1) + (xcd - r) * q) + off; }
        const int nig = WGM * nN, gid = wgid / nig, fm = gid * WGM, gsz = (nM - fm) < WGM ? (nM - fm) : WGM;
        u.pm = fm + ((wgid % nig) % gsz); u.pn = (wgid % nig) / gsz; return true;
    }
    __device__ __forceinline__ void a_ready(const Unit&) const {}
    __device__ __forceinline__ void done(const Unit&) const {}
};

__device__ __forceinline__ unsigned cvt_pk_bf16(float lo, float hi) { unsigned r; asm volatile("v_cvt_pk_bf16_f32 %0, %1, %2" : "=v"(r) : "v"(lo), "v"(hi)); return r; }
template <int ACT  > struct EpiBf16 {
    static constexpr bool PERM = true, AFTER_DRAIN = false;
    bf16_t* O; int ldc;
    __device__ __forceinline__ void operator()(const f32x4 (&acc)[2][2][4][2], const Unit& u, int wr, int wc, int fr, int fq) const {
        const int row0 = u.pm * BM + wr * 64 + fr; const int col0 = u.pn * BM + wc * 32 + 8 * fq;
#pragma unroll
        for (int ai = 0; ai < 2; ++ai)
#pragma unroll
            for (int m = 0; m < 4; ++m) { bf16_t* rowp = O + (size_t)(row0 + ai * HALF + m * 16) * ldc + col0;
#pragma unroll
                for (int bj = 0; bj < 2; ++bj) { f32x4 v0 = acc[ai][bj][m][0], v1 = acc[ai][bj][m][1];
                    if (ACT == 2) {
#pragma unroll
                        for (int e = 0; e < 4; ++e) { float a = v0[e] > 0.f ? v0[e] : 0.f; v0[e] = a * a; float b = v1[e] > 0.f ? v1[e] : 0.f; v1[e] = b * b; } }
                    u32x4 w; w.x = cvt_pk_bf16(v0[0], v0[1]); w.y = cvt_pk_bf16(v0[2], v0[3]); w.z = cvt_pk_bf16(v1[0], v1[1]); w.w = cvt_pk_bf16(v1[2], v1[3]);
                    *(u32x4*)(rowp + bj * HALF) = w; } }
    }
};
struct EpiRes {
    static constexpr bool PERM = false, AFTER_DRAIN = false;
    const float* base; float* out; int ldc; float alpha;
    __device__ __forceinline__ void operator()(const f32x4 (&acc)[2][2][4][2], const Unit& u, int wr, int wc, int fr, int fq) const {
        const int col0 = u.pn * BM + wc * 32 + 4 * fq;
#pragma unroll
        for (int ai = 0; ai < 2; ++ai)
#pragma unroll
            for (int m = 0; m < 4; ++m) { const size_t off = (size_t)(u.pm * BM + ai * HALF + wr * 64 + m * 16 + fr) * ldc + col0;
#pragma unroll
                for (int bj = 0; bj < 2; ++bj)
#pragma unroll
                    for (int n = 0; n < 2; ++n) { const f32x4 bs = *(const f32x4*)(base + off + bj * HALF + n * 16);
                        *(f32x4*)(out + off + bj * HALF + n * 16) = bs * alpha + acc[ai][bj][m][n]; }
                asm volatile("" ::: "memory"); }
    }
};
template <class Epi, class Sched, bool ALIGN_EPI = false, bool SP2 = false>
__device__ __forceinline__ void gemm_phase(PG8_LAS unsigned char* lds, const Gemm g, const Sched& S, const Epi& E) {
    const int tid = threadIdx.x, wid = __builtin_amdgcn_readfirstlane(tid >> 6), lane = tid & 63, wr = wid >> 2, wc = wid & 3, fr = lane & 15, fq = lane >> 4;
    const int K = g.K, nt = K / BK;
    unsigned voffA[2], voffB[2];
#pragma unroll
    for (int i = 0; i < 2; ++i) { int R, C; stage_rc(tid * 16 + i * 8192, R, C); const int Rb = Epi::PERM ? ((R & ~31) + perm32(R & 31)) : R;
        voffA[i] = (unsigned)(R * K + C) * 2u; voffB[i] = (unsigned)(Rb * K + C) * 2u; }
    const size_t kstep = (size_t)(BK * 2);
    const size_t hstep = (size_t)HALF * K * 2;
    const size_t tstep = 2 * hstep;
    const unsigned ldsw = (unsigned)wid * 1024u;
    const int aoff = lds_byte(wr * 64 + fr, fq * 8), boff = lds_byte(wc * 32 + fr, fq * 8);
#define PG8_SA(b, h) (((b) * 2 + (h)) * HTB)
#define PG8_SB(b, h) ((4 + (b) * 2 + (h)) * HTB)
#define PG8_STAGE(bufoff, gbase, voff) do { _Pragma("unroll") for (int _i = 0; _i < 2; ++_i) \
        __builtin_amdgcn_global_load_lds((const unsigned*)((const char*)(gbase) + (voff)[_i]), (PG8_LAS unsigned*)(lds + (bufoff) + ldsw + _i * 8192), 16, 0, 0); } while (0)
#define PG8_LDA(dst, b, h) do { _Pragma("unroll") for (int m = 0; m < 4; ++m) _Pragma("unroll") for (int k = 0; k < 2; ++k) dst[m][k] = *(const PG8_LAS bf16x8*)(lds + PG8_SA(b, h) + aoff + m * 2048 + k * 1024); } while (0)
#define PG8_LDB(dst, b, h) do { _Pragma("unroll") for (int n = 0; n < 2; ++n) _Pragma("unroll") for (int k = 0; k < 2; ++k) dst[n][k] = *(const PG8_LAS bf16x8*)(lds + PG8_SB(b, h) + boff + n * 2048 + k * 1024); } while (0)
#define PG8_MMA(ai, bj, At, Bt) do { __builtin_amdgcn_s_setprio(1); _Pragma("unroll") for (int m = 0; m < 4; ++m) _Pragma("unroll") for (int n = 0; n < 2; ++n) _Pragma("unroll") for (int k = 0; k < 2; ++k) \
        acc[ai][bj][m][n] = __builtin_amdgcn_mfma_f32_16x16x32_bf16(Bt[n][k], At[m][k], acc[ai][bj][m][n], 0, 0, 0); __builtin_amdgcn_s_setprio(0); } while (0)
#define PG8_WAIT_V(n) asm volatile("s_waitcnt vmcnt(" #n ")" ::: "memory")
#define PG8_WAIT_L(n) asm volatile("s_waitcnt lgkmcnt(" #n ")" ::: "memory")
#define PG8_BAR __builtin_amdgcn_s_barrier()
#define PG8_SCHED __builtin_amdgcn_sched_barrier(0)
    Unit cur, nxt; int ui = 0;
    if (!S.next(0, cur)) return;
    f32x4 acc[2][2][4][2];
#pragma unroll
    for (int a = 0; a < 2; ++a)
#pragma unroll
        for (int b = 0; b < 2; ++b)
#pragma unroll
            for (int m = 0; m < 4; ++m)
#pragma unroll
                for (int n = 0; n < 2; ++n) acc[a][b][m][n] = (f32x4){0.f, 0.f, 0.f, 0.f};
    bf16x8 At[4][2], B0[2][2], B1[2][2];
    const char* cA = (const char*)g.A + (size_t)cur.pm * tstep; const char* cB = (const char*)g.Bt + (size_t)cur.pn * tstep;
    S.a_ready(cur);
    if constexpr (SP2) {
        PG8_STAGE(PG8_SB(0, 0), cB, voffB); PG8_STAGE(PG8_SB(0, 1), cB + hstep, voffB); PG8_STAGE(PG8_SA(0, 0), cA, voffA); PG8_STAGE(PG8_SA(0, 1), cA + hstep, voffA);
        if (wr == 1) PG8_BAR;
        PG8_WAIT_V(2); PG8_BAR;
        PG8_STAGE(PG8_SB(1, 0), cB + kstep, voffB); PG8_STAGE(PG8_SA(1, 0), cA + kstep, voffA); PG8_STAGE(PG8_SB(1, 1), cB + hstep + kstep, voffB);
        PG8_WAIT_V(6); PG8_BAR;
    } else {
        PG8_STAGE(PG8_SB(0, 0), cB, voffB); PG8_STAGE(PG8_SA(0, 0), cA, voffA); PG8_STAGE(PG8_SB(0, 1), cB + hstep, voffB); PG8_STAGE(PG8_SA(0, 1), cA + hstep, voffA);
        if (wr == 1) PG8_BAR;
        PG8_WAIT_V(4); PG8_BAR;
        PG8_STAGE(PG8_SB(1, 0), cB + kstep, voffB); PG8_STAGE(PG8_SA(1, 0), cA + kstep, voffA); PG8_STAGE(PG8_SB(1, 1), cB + hstep + kstep, voffB);
        PG8_WAIT_V(6); PG8_BAR;
    }
    for (;;) {
        const bool has_next = S.next(ui + 1, nxt);
        const char* nA = has_next ? (const char*)g.A + (size_t)nxt.pm * tstep : cA; const char* nB = has_next ? (const char*)g.Bt + (size_t)nxt.pn * tstep : cB;
        for (int t = 0; t < nt; t += 2) {
            const bool last = (t == nt - 2);
            const char* a1 = cA + (size_t)(t + 1) * kstep;
            const char* a2 = last ? nA : cA + (size_t)(t + 2) * kstep; const char* b2 = last ? nB : cB + (size_t)(t + 2) * kstep;
            const char* a3 = a2 + kstep; const char* b3 = b2 + kstep;
            if (last && has_next) S.a_ready(nxt);
            if constexpr (SP2) {
            PG8_LDB(B0, 0, 0); PG8_LDB(B1, 0, 1); PG8_SCHED; PG8_LDA(At, 0, 0); PG8_STAGE(PG8_SA(1, 1), a1 + hstep, voffA);
            PG8_WAIT_V(8); PG8_WAIT_L(0); PG8_BAR; PG8_MMA(0, 0, At, B0); PG8_MMA(0, 1, At, B1); PG8_BAR; PG8_SCHED;
            PG8_LDA(At, 0, 1); PG8_STAGE(PG8_SB(0, 0), b2, voffB); PG8_STAGE(PG8_SB(0, 1), b2 + hstep, voffB); PG8_STAGE(PG8_SA(0, 0), a2, voffA);
            PG8_WAIT_V(8); PG8_WAIT_L(0); PG8_BAR; PG8_MMA(1, 0, At, B0); PG8_MMA(1, 1, At, B1); PG8_BAR; PG8_SCHED;
            PG8_LDB(B0, 1, 0); PG8_LDB(B1, 1, 1); PG8_SCHED; PG8_LDA(At, 1, 0); PG8_STAGE(PG8_SA(0, 1), a2 + hstep, voffA);
            PG8_WAIT_V(8); PG8_WAIT_L(0); PG8_BAR; PG8_MMA(0, 0, At, B0); PG8_MMA(0, 1, At, B1); PG8_BAR; PG8_SCHED;
            PG8_LDA(At, 1, 1); PG8_STAGE(PG8_SB(1, 0), b3, voffB); PG8_STAGE(PG8_SB(1, 1), b3 + hstep, voffB); PG8_STAGE(PG8_SA(1, 0), a3, voffA);
            PG8_WAIT_V(8); PG8_WAIT_L(0); PG8_BAR; PG8_MMA(1, 0, At, B0); PG8_MMA(1, 1, At, B1); PG8_BAR; PG8_SCHED;
            } else {
            PG8_LDB(B0, 0, 0); PG8_SCHED; PG8_LDA(At, 0, 0); PG8_STAGE(PG8_SA(1, 1), a1 + hstep, voffA);
            PG8_WAIT_L(8); PG8_BAR; PG8_WAIT_L(0); PG8_MMA(0, 0, At, B0); PG8_BAR; PG8_SCHED;
            PG8_LDB(B1, 0, 1); PG8_STAGE(PG8_SB(0, 0), b2, voffB);
            PG8_BAR; PG8_WAIT_L(0); PG8_MMA(0, 1, At, B1); PG8_BAR;
            PG8_LDA(At, 0, 1); PG8_STAGE(PG8_SA(0, 0), a2, voffA);
            PG8_BAR; PG8_WAIT_L(0); PG8_MMA(1, 0, At, B0); PG8_BAR; PG8_SCHED;
            PG8_STAGE(PG8_SB(0, 1), b2 + hstep, voffB);
            PG8_WAIT_V(6); PG8_BAR; PG8_MMA(1, 1, At, B1); PG8_BAR;
            PG8_LDB(B0, 1, 0); PG8_SCHED; PG8_LDA(At, 1, 0); PG8_STAGE(PG8_SA(0, 1), a2 + hstep, voffA);
            PG8_WAIT_L(8); PG8_BAR; PG8_WAIT_L(0); PG8_MMA(0, 0, At, B0); PG8_BAR; PG8_SCHED;
            PG8_LDB(B1, 1, 1); PG8_STAGE(PG8_SB(1, 0), b3, voffB);
            PG8_BAR; PG8_WAIT_L(0); PG8_MMA(0, 1, At, B1); PG8_BAR;
            PG8_LDA(At, 1, 1); PG8_STAGE(PG8_SA(1, 0), a3, voffA);
            PG8_BAR; PG8_WAIT_L(0); PG8_MMA(1, 0, At, B0); PG8_BAR; PG8_SCHED;
            PG8_STAGE(PG8_SB(1, 1), b3 + hstep, voffB);
            PG8_WAIT_V(6); PG8_BAR; PG8_MMA(1, 1, At, B1); PG8_BAR;
            }
        }
        if constexpr (ALIGN_EPI) { if (wr == 0) PG8_BAR; }
        if constexpr (!Epi::AFTER_DRAIN) { E(acc, cur, wr, wc, fr, fq); S.done(cur); }
        if (!has_next) break;
#pragma unroll
        for (int a = 0; a < 2; ++a)
#pragma unroll
            for (int b = 0; b < 2; ++b)
#pragma unroll
                for (int m = 0; m < 4; ++m)
#pragma unroll
                    for (int n = 0; n < 2; ++n) acc[a][b][m][n] = (f32x4){0.f, 0.f, 0.f, 0.f};
        cur = nxt; cA = nA; cB = nB; ++ui;
        if constexpr (ALIGN_EPI) { if (wr == 1) PG8_BAR; }
    }
    PG8_WAIT_V(0);
    if constexpr (!ALIGN_EPI) { if (wr == 0) PG8_BAR; }
    PG8_BAR;
    if constexpr (Epi::AFTER_DRAIN) { E.fused(acc, cur, wr, wc, fr, fq, lds, wid, lane); S.done(cur); }
#undef PG8_SA
#undef PG8_SB
#undef PG8_STAGE
#undef PG8_LDA
#undef PG8_LDB
#undef PG8_MMA
#undef PG8_WAIT_V
#undef PG8_WAIT_L
#undef PG8_BAR
#undef PG8_SCHED
}
}

#define LAS __attribute__((address_space(3)))
typedef unsigned short bf16;
typedef short bf16x8 __attribute__((ext_vector_type(8)));
typedef float f32x4 __attribute__((ext_vector_type(4)));
typedef unsigned u32x4 __attribute__((ext_vector_type(4)));
typedef unsigned u32x2 __attribute__((ext_vector_type(2)));

constexpr int NB = 8, SEQ = 2048, DM = 1024, MTOK = NB * SEQ, DIN = 3176, DINP = 3328, DFF = 4096;
constexpr int HA_Q = 0, HA_K = 256, HA_V = 512, HA_A = 768, HA_B = 772, HA_Z = 776;
constexpr int HB_CQ = 1032, HB_CKV = 1224, HB_KR = 1352;
constexpr int HC_Q = 1384, HC_F = 1640, HC_I = 1896, HC_G = 2152;
constexpr int HD_Q = 2408, HD_K = 2664, HD_V = 2920;
constexpr float ALPHA = 1.4142135623730951f, EPS = 1e-6f, LOG2E = 1.4426950408889634f;

constexpr size_t MiB = 1u << 20;
constexpr size_t WS_CTL = 0;
constexpr size_t WS_WIN = 1 * MiB;
constexpr size_t WS_WOUT = WS_WIN + 6656 * 1024;
constexpr size_t WS_WUQ = WS_WOUT + 2 * MiB;
constexpr size_t WS_WUKV = WS_WUQ + 256 * 1024;
constexpr size_t WS_XB = 10 * MiB;
constexpr size_t WS_H = 42 * MiB;
constexpr size_t WS_T = 146 * MiB;
constexpr size_t WS_CVT = WS_T;
constexpr size_t WS_CAS = WS_T + 8 * MiB;
constexpr size_t WS_DVT = WS_T + 12 * MiB;
constexpr size_t WS_EGL = WS_T + 20 * MiB;
constexpr size_t WS_ECL = WS_T + 21 * MiB;
constexpr size_t WS_X2 = 170 * MiB;
constexpr size_t WS_W1 = WS_X2;
constexpr size_t WS_W2 = WS_X2 + 8 * MiB;
constexpr size_t WS_GU = WS_X2;
constexpr size_t WS_GW = WS_X2 + 8 * MiB;
constexpr size_t WS_GQD = WS_X2 + 16 * MiB;
constexpr size_t WS_GKDT = WS_X2 + 24 * MiB;
constexpr size_t WS_GQK = WS_X2 + 32 * MiB;
constexpr size_t WS_MQ = WS_X2 + 40 * MiB;
constexpr size_t WS_MKN = WS_X2 + 52 * MiB;
constexpr size_t WS_MKR = WS_X2 + 60 * MiB;
constexpr size_t WS_MVT = WS_X2 + 61 * MiB;
constexpr size_t WS_CQT = WS_X2 + 69 * MiB;
constexpr size_t WS_CKDT = WS_X2 + 77 * MiB;
constexpr size_t WS_END = 256 * MiB;

constexpr int LDS_BYTES = 131072 + 1024;

__device__ __forceinline__ float bf2f(unsigned short h) { return __uint_as_float(((unsigned)h) << 16); }
__device__ __forceinline__ unsigned short f2bf(float f) { unsigned u = __float_as_uint(f); return (unsigned short)((u + 0x7fffu + ((u >> 16) & 1u)) >> 16); }
__device__ __forceinline__ unsigned pk2(float lo, float hi) { return (unsigned)f2bf(lo) | ((unsigned)f2bf(hi) << 16); }
__device__ __forceinline__ float bfw(unsigned w, int hi) { return hi ? __uint_as_float(w & 0xffff0000u) : __uint_as_float(w << 16); }
__device__ __forceinline__ float sigmoidf_(float x) { return 1.f / (1.f + __expf(-x)); }
__device__ __forceinline__ float siluf_(float x) { return x / (1.f + __expf(-x)); }
#define MFMA16(a, b, c) __builtin_amdgcn_mfma_f32_16x16x32_bf16((a), (b), (c), 0, 0, 0)
#define WAVE_SYNC() asm volatile("s_waitcnt lgkmcnt(0)" ::: "memory")
__device__ __forceinline__ bf16x8 ldg8(const bf16* p) { return *(const bf16x8*)p; }
__device__ __forceinline__ bf16x8 lds8(const LAS bf16* p) { return *(const LAS bf16x8*)p; }

struct Args { const float* in[19]; float* out; unsigned char* ws; int ph_lo, ph_hi; };

__device__ __forceinline__ void tr_item(const float* __restrict__ W, int K, int N, bf16* __restrict__ WT, LAS float* scr, int item, int lane) {
    const int nblk = (N + 31) >> 5, kb = item / nblk, nb = item - kb * nblk, k0 = 64 * kb, n0 = 32 * nb;
    const int n = n0 + (lane & 31);
#pragma unroll 8
    for (int i = 0; i < 32; ++i) { const int kk = 2 * i + (lane >> 5); scr[kk * 33 + (lane & 31)] = (n < N) ? W[(size_t)(k0 + kk) * N + n] : 0.f; }
    WAVE_SYNC();
    const int c = lane & 7;
#pragma unroll
    for (int j = 0; j < 4; ++j) { const int nn = (lane >> 3) + 8 * j; const LAS float* s = scr + (8 * c) * 33 + nn;
        u32x4 o; o.x = pk2(s[0 * 33], s[1 * 33]); o.y = pk2(s[2 * 33], s[3 * 33]); o.z = pk2(s[4 * 33], s[5 * 33]); o.w = pk2(s[6 * 33], s[7 * 33]);
        *(u32x4*)(WT + (size_t)(n0 + nn) * K + k0 + 8 * c) = o; }
    WAVE_SYNC();
}
__device__ __forceinline__ float wave_sum(float v) {
#pragma unroll
    for (int o = 1; o < 64; o <<= 1) v += __shfl_xor(v, o);
    return v;
}
__device__ __forceinline__ void convert_weights(const Args& a, int l, int which, LAS unsigned char* lds, int gw, int NGW, int wave, int lane) {
    LAS float* scr = (LAS float*)(lds + wave * 16384);
    unsigned char* ws = a.ws;
    if (which == 0) {
        constexpr int I_IN = 16 * 100, I_OUT = 16 * 32, I_UQ = 3 * 12, I_UKV = 2 * 16, NIT = I_IN + I_OUT + I_UQ + I_UKV;
        for (int it = gw; it < NIT; it += NGW) {
            int r = it;
            if (r < I_IN) { tr_item(a.in[1] + (size_t)l * DM * DIN, DM, DIN, (bf16*)(ws + WS_WIN), scr, r, lane); continue; } r -= I_IN;
            if (r < I_OUT) { tr_item(a.in[12] + (size_t)l * DM * DM, DM, DM, (bf16*)(ws + WS_WOUT), scr, r, lane); continue; } r -= I_OUT;
            if (r < I_UQ) { tr_item(a.in[8] + (size_t)l * 192 * 384, 192, 384, (bf16*)(ws + WS_WUQ), scr, r, lane); continue; } r -= I_UQ;
            tr_item(a.in[9] + (size_t)l * 128 * 512, 128, 512, (bf16*)(ws + WS_WUKV), scr, r, lane);
        }
        u32x4 z = {0u, 0u, 0u, 0u};
        for (int i = gw * 64 + lane; i < 16384; i += NGW * 64) *(u32x4*)(ws + WS_WIN + (size_t)3200 * 2048 + (size_t)i * 16) = z;
    } else {
        constexpr int I_1 = 16 * 128, I_2 = 64 * 32, NIT = I_1 + I_2;
        for (int it = gw; it < NIT; it += NGW) {
            if (it < I_1) tr_item(a.in[15] + (size_t)l * DM * DFF, DM, DFF, (bf16*)(ws + WS_W1), scr, it, lane);
            else tr_item(a.in[16] + (size_t)l * DFF * DM, DFF, DM, (bf16*)(ws + WS_W2), scr, it - I_1, lane);
        }
    }
}
__device__ __forceinline__ void ln_row(const float* yrow, float* xo, bf16* xb, const float* g, const float* bb, int lane) {
    const f32x4* yr = (const f32x4*)yrow + lane;
    f32x4 v[4]; float s = 0.f;
#pragma unroll
    for (int j = 0; j < 4; ++j) { v[j] = yr[64 * j]; s += (v[j].x + v[j].y) + (v[j].z + v[j].w); }
    const float mean = wave_sum(s) * (1.f / DM); float s2 = 0.f;
#pragma unroll
    for (int j = 0; j < 4; ++j) { v[j] = v[j] - mean; s2 += (v[j].x * v[j].x + v[j].y * v[j].y) + (v[j].z * v[j].z + v[j].w * v[j].w); }
    const float rstd = 1.f / sqrtf(wave_sum(s2) * (1.f / DM) + EPS);
#pragma unroll
    for (int j = 0; j < 4; ++j) { const f32x4 gg = ((const f32x4*)g)[lane + 64 * j], b4 = ((const f32x4*)bb)[lane + 64 * j];
        f32x4 o = v[j] * rstd * gg + b4;
        ((f32x4*)xo)[lane + 64 * j] = o;
        u32x2 w; w.x = pk2(o.x, o.y); w.y = pk2(o.z, o.w); ((u32x2*)xb)[lane + 64 * j] = w; }
}

__device__ __forceinline__ void gdn_prep_item(const Args& a, int l, int item, LAS unsigned char* lds, int tid) {
    const int bh = item >> 5, n = item & 31, b = bh >> 2, hh = bh & 3, t0 = n * 64;
    const int lane = tid & 63, wave = tid >> 6, r = lane & 15, q = lane >> 4;
    unsigned char* ws = a.ws;
    const bf16* H = (const bf16*)(ws + WS_H);
    LAS bf16* Kb = (LAS bf16*)lds;
    LAS bf16* Qb = Kb + 64 * 72;
    LAS bf16* Vb = Qb + 64 * 72;
    LAS float* Lm = (LAS float*)(lds + 27648);
    LAS float* gcs = (LAS float*)(lds + 27648 + 16384);
    LAS float* bet = gcs + 64;
    {
        const int tok = tid >> 3, seg = tid & 7, t = t0 + tok;
        float qa[8], ka[8], va[8];
#pragma unroll
        for (int e = 0; e < 8; ++e) { qa[e] = 0.f; ka[e] = 0.f; va[e] = 0.f; }
        const float* cw = a.in[2] + (size_t)l * 4 * 768;
#pragma unroll
        for (int j = 0; j < 4; ++j) {
            const int tt = t - 3 + j;
            if (tt >= 0) {
                const bf16* row = H + (size_t)(b * SEQ + tt) * DINP;
                const u32x4 xq = *(const u32x4*)(row + HA_Q + hh * 64 + seg * 8);
                const u32x4 xk = *(const u32x4*)(row + HA_K + hh * 64 + seg * 8);
                const u32x4 xv = *(const u32x4*)(row + HA_V + hh * 64 + seg * 8);
                const float* wq = cw + j * 768 + HA_Q + hh * 64 + seg * 8;
                const float* wk = cw + j * 768 + HA_K + hh * 64 + seg * 8;
                const float* wv = cw + j * 768 + HA_V + hh * 64 + seg * 8;
#pragma unroll
                for (int e = 0; e < 8; ++e) {
                    qa[e] += wq[e] * bfw(xq[e >> 1], e & 1);
                    ka[e] += wk[e] * bfw(xk[e >> 1], e & 1);
                    va[e] += wv[e] * bfw(xv[e >> 1], e & 1);
                }
            }
        }
        float sq = 0.f, sk = 0.f;
#pragma unroll
        for (int e = 0; e < 8; ++e) { qa[e] = siluf_(qa[e]); ka[e] = siluf_(ka[e]); va[e] = siluf_(va[e]); sq += qa[e] * qa[e]; sk += ka[e] * ka[e]; }
        sq += __shfl_xor(sq, 1); sq += __shfl_xor(sq, 2); sq += __shfl_xor(sq, 4);
        sk += __shfl_xor(sk, 1); sk += __shfl_xor(sk, 2); sk += __shfl_xor(sk, 4);
        const float rq = rsqrtf(sq + EPS) * 0.125f, rk = rsqrtf(sk + EPS);
        u32x4 oq, ok, ov;
        oq.x = pk2(qa[0] * rq, qa[1] * rq); oq.y = pk2(qa[2] * rq, qa[3] * rq); oq.z = pk2(qa[4] * rq, qa[5] * rq); oq.w = pk2(qa[6] * rq, qa[7] * rq);
        ok.x = pk2(ka[0] * rk, ka[1] * rk); ok.y = pk2(ka[2] * rk, ka[3] * rk); ok.z = pk2(ka[4] * rk, ka[5] * rk); ok.w = pk2(ka[6] * rk, ka[7] * rk);
        ov.x = pk2(va[0], va[1]); ov.y = pk2(va[2], va[3]); ov.z = pk2(va[4], va[5]); ov.w = pk2(va[6], va[7]);
        *(LAS u32x4*)(Qb + tok * 72 + seg * 8) = oq;
        *(LAS u32x4*)(Kb + tok * 72 + seg * 8) = ok;
        *(LAS u32x4*)(Vb + tok * 72 + seg * 8) = ov;
        if (seg == 0) {
            const bf16* row = H + (size_t)(b * SEQ + t) * DINP;
            const float av = bf2f(row[HA_A + hh]), bv = bf2f(row[HA_B + hh]);
            const float xs = av + a.in[4][l * 4 + hh];
            const float sp = xs > 20.f ? xs : log1pf(__expf(xs));
            gcs[tok] = -__expf(a.in[3][l * 4 + hh]) * sp;
            bet[tok] = sigmoidf_(bv);
        }
    }
    __syncthreads();
    if (wave == 0) {
        float v = gcs[lane];
#pragma unroll
        for (int o = 1; o < 64; o <<= 1) { const float t = __shfl_up(v, o); if (lane >= o) v += t; }
        gcs[lane] = v;
    }
    __syncthreads();
    {
        const int it = wave >> 1, jt0 = (wave & 1) * 2;
        bf16* QKg = (bf16*)(ws + WS_GQK) + (size_t)(bh * 32 + n) * 4096;
        bf16x8 ak[2], aq[2];
#pragma unroll
        for (int ks = 0; ks < 2; ++ks) { ak[ks] = lds8(Kb + (16 * it + r) * 72 + 32 * ks + 8 * q); aq[ks] = lds8(Qb + (16 * it + r) * 72 + 32 * ks + 8 * q); }
#pragma unroll
        for (int jj2 = 0; jj2 < 2; ++jj2) {
            const int jt = jt0 + jj2;
            f32x4 ckk = {0.f, 0.f, 0.f, 0.f}, cqk = {0.f, 0.f, 0.f, 0.f};
#pragma unroll
            for (int ks = 0; ks < 2; ++ks) { const bf16x8 bk = lds8(Kb + (16 * jt + r) * 72 + 32 * ks + 8 * q); ckk = MFMA16(ak[ks], bk, ckk); cqk = MFMA16(aq[ks], bk, cqk); }
            const int j = 16 * jt + r; const float gj = gcs[j];
#pragma unroll
            for (int e = 0; e < 4; ++e) {
                const int i = 16 * it + 4 * q + e; const float gi = gcs[i];
                const float dec = (j <= i) ? __expf(gi - gj) : 0.f;
                Lm[i * 64 + j] = (j < i) ? bet[i] * ckk[e] * dec : 0.f;
                QKg[i * 64 + j] = f2bf(cqk[e] * dec);
            }
        }
    }
    __syncthreads();
    if (tid < 128) {
        const int c = tid;
        LAS float* X = (LAS float*)(lds + 45056);
        for (int i = 0; i < 64; ++i) X[i * 128 + c] = 0.f;
        bf16* dst = (c < 64) ? (bf16*)(ws + WS_GU) + (size_t)(bh * SEQ + t0) * 64 + c : (bf16*)(ws + WS_GW) + (size_t)(bh * SEQ + t0) * 64 + (c - 64);
        for (int i = 0; i < 64; ++i) {
            const float bi = bet[i];
            float acc = (c < 64) ? bf2f(Vb[i * 72 + c]) * bi : bf2f(Kb[i * 72 + (c - 64)]) * bi * __expf(gcs[i]);
            const int n4 = (i + 3) >> 2;
            for (int j4 = 0; j4 < n4; ++j4) {
                const f32x4 lv = *(const LAS f32x4*)(Lm + i * 64 + 4 * j4);
                acc -= lv[0] * X[(4 * j4 + 0) * 128 + c]; acc -= lv[1] * X[(4 * j4 + 1) * 128 + c];
                acc -= lv[2] * X[(4 * j4 + 2) * 128 + c]; acc -= lv[3] * X[(4 * j4 + 3) * 128 + c];
            }
            X[i * 128 + c] = acc;
            dst[i * 64] = f2bf(acc);
        }
    } else {
        const float glast = gcs[63];
        bf16* QD = (bf16*)(ws + WS_GQD) + (size_t)(bh * SEQ + t0) * 64;
        bf16* KDT = (bf16*)(ws + WS_GKDT) + (size_t)(bh * 32 + n) * 4096;
        for (int task = tid - 128; task < 512; task += 384) {
            {
                const int tok = task >> 3, seg = task & 7; const float eg = __expf(gcs[tok]);
                const u32x4 xq = *(const LAS u32x4*)(Qb + tok * 72 + seg * 8);
                u32x4 o; o.x = pk2(bfw(xq.x, 0) * eg, bfw(xq.x, 1) * eg); o.y = pk2(bfw(xq.y, 0) * eg, bfw(xq.y, 1) * eg);
                o.z = pk2(bfw(xq.z, 0) * eg, bfw(xq.z, 1) * eg); o.w = pk2(bfw(xq.w, 0) * eg, bfw(xq.w, 1) * eg);
                *(u32x4*)(QD + tok * 64 + seg * 8) = o;
            }
            {
                const int d = task >> 3, is = task & 7; float kv[8];
#pragma unroll
                for (int e = 0; e < 8; ++e) { const int i = is * 8 + e; kv[e] = bf2f(Kb[i * 72 + d]) * __expf(glast - gcs[i]); }
                u32x4 o; o.x = pk2(kv[0], kv[1]); o.y = pk2(kv[2], kv[3]); o.z = pk2(kv[4], kv[5]); o.w = pk2(kv[6], kv[7]);
                *(u32x4*)(KDT + d * 64 + is * 8) = o;
            }
        }
        if (tid == 128) ((float*)(ws + WS_EGL))[bh * 32 + n] = __expf(glast);
    }
    __syncthreads();
}

__device__ __forceinline__ void hgrn_prep_item(const Args& a, int l, int item, LAS unsigned char* lds, int tid) {
    const int b = item >> 6, ch = item & 63, t0 = ch * 32;
    const int lane = tid & 63, wave = tid >> 6, r = lane & 15, q = lane >> 4;
    unsigned char* ws = a.ws;
    const bf16* H = (const bf16*)(ws + WS_H);
    LAS bf16* Qt = (LAS bf16*)lds;
    LAS bf16* Kt = Qt + 32 * 264;
    if (tid < 256) {
        const int c = tid;
        float lb = 0.f;
        if (l == 1) lb = 1.f / (1.f + __expf(a.in[10][c] - a.in[10][256 + c]));
        const float oml = 1.f - lb;
        float cum = 0.f; float kt[32]; unsigned vt[16];
        bf16* QT = (bf16*)(ws + WS_CQT) + (size_t)(b * SEQ + t0) * 256 + c;
#pragma unroll
        for (int t = 0; t < 32; ++t) {
            const bf16* row = H + (size_t)(b * SEQ + t0 + t) * DINP;
            const float fl = bf2f(row[HC_F + c]), qv = bf2f(row[HC_Q + c]); const unsigned iv = row[HC_I + c];
            const float sg = 1.f / (1.f + __expf(-fl));
            const float f = lb + oml * sg;
            cum += __logf(f);
            const float kk = oml / (1.f + __expf(fl));
            const float qt = qv * __expf(cum), ktl = kk * __expf(-cum);
            const bf16 qb = f2bf(qt);
            Qt[t * 264 + c] = qb; Kt[t * 264 + c] = f2bf(ktl); kt[t] = ktl;
            QT[(size_t)t * 256] = qb;
            if (t & 1) vt[t >> 1] |= iv << 16; else vt[t >> 1] = iv;
        }
        const float ecl = __expf(cum);
        ((float*)(ws + WS_ECL))[(size_t)(b * 64 + ch) * 256 + c] = ecl;
        bf16* KD = (bf16*)(ws + WS_CKDT) + ((size_t)(b * 64 + ch) * 256 + c) * 32;
        bf16* VT = (bf16*)(ws + WS_CVT) + ((size_t)(b * 64 + ch) * 256 + c) * 32;
#pragma unroll
        for (int g4 = 0; g4 < 4; ++g4) {
            u32x4 o; o.x = pk2(kt[8 * g4 + 0] * ecl, kt[8 * g4 + 1] * ecl); o.y = pk2(kt[8 * g4 + 2] * ecl, kt[8 * g4 + 3] * ecl);
            o.z = pk2(kt[8 * g4 + 4] * ecl, kt[8 * g4 + 5] * ecl); o.w = pk2(kt[8 * g4 + 6] * ecl, kt[8 * g4 + 7] * ecl);
            *(u32x4*)(KD + 8 * g4) = o;
            u32x4 v; v.x = vt[4 * g4 + 0]; v.y = vt[4 * g4 + 1]; v.z = vt[4 * g4 + 2]; v.w = vt[4 * g4 + 3];
            *(u32x4*)(VT + 8 * g4) = v;
        }
    }
    __syncthreads();
    {
        const int hh = wave >> 1, tt = wave & 1;
        bf16* AS = (bf16*)(ws + WS_CAS) + ((size_t)((b * 4 + hh) * 64 + ch) * 32) * 32;
        bf16x8 aq[2];
#pragma unroll
        for (int ks = 0; ks < 2; ++ks) aq[ks] = lds8(Qt + (16 * tt + r) * 264 + hh * 64 + 32 * ks + 8 * q);
#pragma unroll
        for (int st = 0; st < 2; ++st) {
            f32x4 acc = {0.f, 0.f, 0.f, 0.f};
#pragma unroll
            for (int ks = 0; ks < 2; ++ks) acc = MFMA16(aq[ks], lds8(Kt + (16 * st + r) * 264 + hh * 64 + 32 * ks + 8 * q), acc);
            const int s = 16 * st + r;
#pragma unroll
            for (int e = 0; e < 4; ++e) { const int t = 16 * tt + 4 * q + e; AS[t * 32 + s] = f2bf(s <= t ? acc[e] : 0.f); }
        }
    }
    __syncthreads();
}

__device__ __forceinline__ void mla_prep_item(const Args& a, int l, int item, LAS unsigned char* lds, int tid) {
    const int g0 = item * 32;
    const int lane = tid & 63, wave = tid >> 6, r = lane & 15, q = lane >> 4;
    unsigned char* ws = a.ws;
    const bf16* H = (const bf16*)(ws + WS_H);
    LAS bf16* Cq = (LAS bf16*)lds;
    LAS bf16* Ckv = Cq + 32 * 200;
    const float LOG2_10000 = 13.287712379549449f;
    {
        const int tok = tid >> 4, sub = tid & 15; const bf16* row = H + (size_t)(g0 + tok) * DINP;
        float xv[12]; float ss = 0.f;
#pragma unroll
        for (int k = 0; k < 3; ++k) { const u32x2 w = *(const u32x2*)(row + HB_CQ + sub * 12 + 4 * k);
            xv[4 * k + 0] = bfw(w.x, 0); xv[4 * k + 1] = bfw(w.x, 1); xv[4 * k + 2] = bfw(w.y, 0); xv[4 * k + 3] = bfw(w.y, 1); }
#pragma unroll
        for (int e = 0; e < 12; ++e) ss += xv[e] * xv[e];
        ss += __shfl_xor(ss, 1); ss += __shfl_xor(ss, 2); ss += __shfl_xor(ss, 4); ss += __shfl_xor(ss, 8);
        const float rq = rsqrtf(ss * (1.f / 192.f) + EPS);
        const float* gq = a.in[6] + l * 192 + sub * 12;
#pragma unroll
        for (int e = 0; e < 12; ++e) Cq[tok * 200 + sub * 12 + e] = f2bf(xv[e] * rq * gq[e]);
        const u32x4 w = *(const u32x4*)(row + HB_CKV + sub * 8);
        float yv[8]; float s2 = 0.f;
#pragma unroll
        for (int e = 0; e < 8; ++e) { yv[e] = bfw(w[e >> 1], e & 1); s2 += yv[e] * yv[e]; }
        s2 += __shfl_xor(s2, 1); s2 += __shfl_xor(s2, 2); s2 += __shfl_xor(s2, 4); s2 += __shfl_xor(s2, 8);
        const float rk = rsqrtf(s2 * (1.f / 128.f) + EPS);
        const float* gk = a.in[7] + l * 128 + sub * 8;
#pragma unroll
        for (int e = 0; e < 8; ++e) Ckv[tok * 136 + sub * 8 + e] = f2bf(yv[e] * rk * gk[e]);
        const int i = sub; const float pos = (float)((g0 + tok) & (SEQ - 1));
        const float ang = pos * exp2f(-(float)i * (LOG2_10000 / 16.f));
        float sn, cs; __sincosf(ang, &sn, &cs);
        const float x1 = bf2f(row[HB_KR + i]), x2 = bf2f(row[HB_KR + 16 + i]);
        bf16* KR = (bf16*)(ws + WS_MKR) + (size_t)(g0 + tok) * 32;
        KR[i] = f2bf(x1 * cs - x2 * sn); KR[16 + i] = f2bf(x1 * sn + x2 * cs);
    }
    __syncthreads();
    {
        const bf16* WUQ = (const bf16*)(ws + WS_WUQ);
        f32x4 acc[3][2];
#pragma unroll
        for (int k = 0; k < 3; ++k) { acc[k][0] = (f32x4){0.f, 0.f, 0.f, 0.f}; acc[k][1] = (f32x4){0.f, 0.f, 0.f, 0.f}; }
#pragma unroll
        for (int ks = 0; ks < 6; ++ks) {
            const bf16x8 a0 = lds8(Cq + r * 200 + 32 * ks + 8 * q), a1 = lds8(Cq + (16 + r) * 200 + 32 * ks + 8 * q);
#pragma unroll
            for (int k = 0; k < 3; ++k) { const bf16x8 bw = ldg8(WUQ + (size_t)(16 * (3 * wave + k) + r) * 192 + 32 * ks + 8 * q);
                acc[k][0] = MFMA16(a0, bw, acc[k][0]); acc[k][1] = MFMA16(a1, bw, acc[k][1]); }
        }
        bf16* MQ = (bf16*)(ws + WS_MQ);
        const float invf = exp2f(-(float)r * (LOG2_10000 / 16.f));
#pragma unroll
        for (int k = 0; k < 3; ++k) {
            const int nt = 3 * wave + k, head = nt / 6, sub = nt - head * 6;
#pragma unroll
            for (int mt = 0; mt < 2; ++mt)
#pragma unroll
                for (int e = 0; e < 4; ++e) {
                    const int g = g0 + 16 * mt + 4 * q + e; bf16* dst = MQ + ((size_t)g * 4 + head) * 96;
                    if (sub < 4) dst[sub * 16 + r] = f2bf(acc[k][mt][e]);
                    else if (sub == 4 && k < 2) {
                        const float pos = (float)(g & (SEQ - 1)); float sn, cs; __sincosf(pos * invf, &sn, &cs);
                        const float x1 = acc[k][mt][e], x2 = acc[(k + 1) % 3][mt][e];
                        dst[64 + r] = f2bf(x1 * cs - x2 * sn); dst[80 + r] = f2bf(x1 * sn + x2 * cs);
                    }
                }
        }
    }
    {
        const bf16* WUKV = (const bf16*)(ws + WS_WUKV);
        f32x4 acc[4][2];
#pragma unroll
        for (int k = 0; k < 4; ++k) { acc[k][0] = (f32x4){0.f, 0.f, 0.f, 0.f}; acc[k][1] = (f32x4){0.f, 0.f, 0.f, 0.f}; }
#pragma unroll
        for (int ks = 0; ks < 4; ++ks) {
            const bf16x8 a0 = lds8(Ckv + r * 136 + 32 * ks + 8 * q), a1 = lds8(Ckv + (16 + r) * 136 + 32 * ks + 8 * q);
#pragma unroll
            for (int k = 0; k < 4; ++k) { const bf16x8 bw = ldg8(WUKV + (size_t)(16 * (4 * wave + k) + r) * 128 + 32 * ks + 8 * q);
                acc[k][0] = MFMA16(a0, bw, acc[k][0]); acc[k][1] = MFMA16(a1, bw, acc[k][1]); }
        }
        const int head = wave >> 1;
        bf16* KN = (bf16*)(ws + WS_MKN); bf16* VT = (bf16*)(ws + WS_MVT);
#pragma unroll
        for (int k = 0; k < 4; ++k)
#pragma unroll
            for (int mt = 0; mt < 2; ++mt)
#pragma unroll
                for (int e = 0; e < 4; ++e) {
                    const int g = g0 + 16 * mt + 4 * q + e;
                    if ((wave & 1) == 0) KN[((size_t)g * 4 + head) * 64 + k * 16 + r] = f2bf(acc[k][mt][e]);
                    else { const int bb = g >> 11, t = g & (SEQ - 1); VT[((size_t)(bb * 4 + head) * 64 + k * 16 + r) * SEQ + (t & 3) * 512 + (t >> 2)] = f2bf(acc[k][mt][e]); }
                }
    }
    __syncthreads();
}

__device__ __forceinline__ void dsa_prep_item(const Args& a, int item, LAS unsigned char* lds, int tid) {
    const int g0 = item * 64, b = g0 >> 11, t0 = g0 & (SEQ - 1);
    unsigned char* ws = a.ws;
    const bf16* H = (const bf16*)(ws + WS_H);
    LAS bf16* Vt = (LAS bf16*)lds;
#pragma unroll
    for (int k = 0; k < 4; ++k) { const int idx = tid + 512 * k, row = idx >> 5, chn = idx & 31;
        *(LAS u32x4*)(Vt + row * 264 + chn * 8) = *(const u32x4*)(H + (size_t)(g0 + row) * DINP + HD_V + chn * 8); }
    __syncthreads();
    const int c = tid & 255, rp = tid >> 8;
    bf16* VT = (bf16*)(ws + WS_DVT) + ((size_t)(b * 4 + (c >> 6)) * 64 + (c & 63)) * SEQ;
#pragma unroll
    for (int k = 0; k < 2; ++k) {
        const int rr = 2 * rp + k; unsigned w[8];
#pragma unroll
        for (int m = 0; m < 8; ++m) w[m] = (unsigned)Vt[(rr + 8 * m) * 264 + c] | ((unsigned)Vt[(rr + 8 * m + 4) * 264 + c] << 16);
        u32x4 o0 = {w[0], w[1], w[2], w[3]}, o1 = {w[4], w[5], w[6], w[7]};
        bf16* dst = VT + rr * 512 + (t0 >> 2);
        *(u32x4*)dst = o0; *(u32x4*)(dst + 8) = o1;
    }
    __syncthreads();
}

__device__ __forceinline__ void norm_gate_store(const f32x4 (&o)[4], const bf16* gate_row  , const float* ng  , bf16* dst  , int q) {
    float ssq = 0.f;
#pragma unroll
    for (int et = 0; et < 4; ++et) ssq += (o[et][0] * o[et][0] + o[et][1] * o[et][1]) + (o[et][2] * o[et][2] + o[et][3] * o[et][3]);
    ssq += __shfl_xor(ssq, 16); ssq += __shfl_xor(ssq, 32);
    const float rinv = rsqrtf(ssq * (1.f / 64.f) + EPS);
#pragma unroll
    for (int et = 0; et < 4; ++et) {
        const int e0 = 16 * et + 4 * q;
        const u32x2 z = *(const u32x2*)(gate_row + e0);
        const f32x4 g4 = *(const f32x4*)(ng + e0);
        const float v0 = o[et][0] * rinv * g4[0] * siluf_(bfw(z.x, 0)), v1 = o[et][1] * rinv * g4[1] * siluf_(bfw(z.x, 1));
        const float v2 = o[et][2] * rinv * g4[2] * siluf_(bfw(z.y, 0)), v3 = o[et][3] * rinv * g4[3] * siluf_(bfw(z.y, 1));
        u32x2 w; w.x = pk2(v0, v1); w.y = pk2(v2, v3);
        *(u32x2*)(dst + e0) = w;
    }
}

__device__ __forceinline__ void gdn_scan(const Args& a, int l, int bh, LAS unsigned char* lds, int lane) {
    const int b = bh >> 2, hh = bh & 3, r = lane & 15, q = lane >> 4;
    unsigned char* ws = a.ws;
    const bf16* H = (const bf16*)(ws + WS_H);
    bf16* CC = (bf16*)(ws + WS_XB);
    LAS bf16* SsT = (LAS bf16*)lds;
    LAS bf16* VnT = SsT + 64 * 72;
    f32x4 st[4][4];
#pragma unroll
    for (int et = 0; et < 4; ++et)
#pragma unroll
        for (int dt = 0; dt < 4; ++dt) st[et][dt] = (f32x4){0.f, 0.f, 0.f, 0.f};
    for (int i = lane; i < 64 * 72 / 2; i += 64) ((LAS unsigned*)SsT)[i] = 0u;
    WAVE_SYNC();
    const float* ng = a.in[5] + l * 64;
    for (int n = 0; n < 32; ++n) {
        const bf16* Ub = (const bf16*)(ws + WS_GU) + (size_t)(bh * SEQ + n * 64) * 64;
        const bf16* Wb = (const bf16*)(ws + WS_GW) + (size_t)(bh * SEQ + n * 64) * 64;
        const bf16* QDb = (const bf16*)(ws + WS_GQD) + (size_t)(bh * SEQ + n * 64) * 64;
        const bf16* KDTb = (const bf16*)(ws + WS_GKDT) + (size_t)(bh * 32 + n) * 4096;
        const bf16* QKb = (const bf16*)(ws + WS_GQK) + (size_t)(bh * 32 + n) * 4096;
        const float eg = ((const float*)(ws + WS_EGL))[bh * 32 + n];
#pragma unroll
        for (int tt = 0; tt < 4; ++tt) {
            const bf16x8 bw0 = ldg8(Wb + (16 * tt + r) * 64 + 8 * q), bw1 = ldg8(Wb + (16 * tt + r) * 64 + 32 + 8 * q);
#pragma unroll
            for (int et = 0; et < 4; ++et) {
                f32x4 acc = {0.f, 0.f, 0.f, 0.f};
                acc = MFMA16(lds8(SsT + (16 * et + r) * 72 + 8 * q), bw0, acc);
                acc = MFMA16(lds8(SsT + (16 * et + r) * 72 + 32 + 8 * q), bw1, acc);
                const u32x2 u4 = *(const u32x2*)(Ub + (16 * tt + r) * 64 + 16 * et + 4 * q);
                const int e0 = 16 * et + 4 * q, t = 16 * tt + r;
                VnT[(e0 + 0) * 72 + t] = f2bf(bfw(u4.x, 0) - acc[0]); VnT[(e0 + 1) * 72 + t] = f2bf(bfw(u4.x, 1) - acc[1]);
                VnT[(e0 + 2) * 72 + t] = f2bf(bfw(u4.y, 0) - acc[2]); VnT[(e0 + 3) * 72 + t] = f2bf(bfw(u4.y, 1) - acc[3]);
            }
        }
        WAVE_SYNC();
#pragma unroll
        for (int it = 0; it < 4; ++it) {
            const bf16x8 bq0 = ldg8(QDb + (16 * it + r) * 64 + 8 * q), bq1 = ldg8(QDb + (16 * it + r) * 64 + 32 + 8 * q);
            const bf16x8 bk0 = ldg8(QKb + (16 * it + r) * 64 + 8 * q), bk1 = ldg8(QKb + (16 * it + r) * 64 + 32 + 8 * q);
            f32x4 o[4];
#pragma unroll
            for (int et = 0; et < 4; ++et) {
                f32x4 acc = {0.f, 0.f, 0.f, 0.f};
                acc = MFMA16(lds8(SsT + (16 * et + r) * 72 + 8 * q), bq0, acc);
                acc = MFMA16(lds8(SsT + (16 * et + r) * 72 + 32 + 8 * q), bq1, acc);
                acc = MFMA16(lds8(VnT + (16 * et + r) * 72 + 8 * q), bk0, acc);
                acc = MFMA16(lds8(VnT + (16 * et + r) * 72 + 32 + 8 * q), bk1, acc);
                o[et] = acc;
            }
            const size_t g = (size_t)b * SEQ + n * 64 + 16 * it + r;
            norm_gate_store(o, H + g * DINP + HA_Z + hh * 64, ng, CC + g * DM + 0 + hh * 64, q);
        }
#pragma unroll
        for (int dt = 0; dt < 4; ++dt) {
            const bf16x8 bk0 = ldg8(KDTb + (16 * dt + r) * 64 + 8 * q), bk1 = ldg8(KDTb + (16 * dt + r) * 64 + 32 + 8 * q);
#pragma unroll
            for (int et = 0; et < 4; ++et) {
                f32x4 acc = st[et][dt] * eg;
                acc = MFMA16(lds8(VnT + (16 * et + r) * 72 + 8 * q), bk0, acc);
                acc = MFMA16(lds8(VnT + (16 * et + r) * 72 + 32 + 8 * q), bk1, acc);
                st[et][dt] = acc;
            }
        }
        WAVE_SYNC();
#pragma unroll
        for (int et = 0; et < 4; ++et)
#pragma unroll
            for (int dt = 0; dt < 4; ++dt)
#pragma unroll
                for (int e = 0; e < 4; ++e) SsT[(16 * et + 4 * q + e) * 72 + 16 * dt + r] = f2bf(st[et][dt][e]);
        WAVE_SYNC();
    }
}

__device__ __forceinline__ void hgrn_scan(const Args& a, int l, int bh, LAS unsigned char* lds, int lane) {
    const int b = bh >> 2, hh = bh & 3, r = lane & 15, q = lane >> 4;
    unsigned char* ws = a.ws;
    const bf16* H = (const bf16*)(ws + WS_H);
    bf16* CC = (bf16*)(ws + WS_XB);
    LAS bf16* SsT = (LAS bf16*)lds;
    f32x4 st[4][4];
#pragma unroll
    for (int et = 0; et < 4; ++et)
#pragma unroll
        for (int dt = 0; dt < 4; ++dt) st[et][dt] = (f32x4){0.f, 0.f, 0.f, 0.f};
    for (int i = lane; i < 64 * 72 / 2; i += 64) ((LAS unsigned*)SsT)[i] = 0u;
    WAVE_SYNC();
    const float* ng = a.in[11] + l * 64;
    for (int ch = 0; ch < 64; ++ch) {
        const size_t g0 = (size_t)b * SEQ + ch * 32;
        const bf16* VTb = (const bf16*)(ws + WS_CVT) + ((size_t)(b * 64 + ch) * 256 + hh * 64) * 32;
        const bf16* KDb = (const bf16*)(ws + WS_CKDT) + ((size_t)(b * 64 + ch) * 256 + hh * 64) * 32;
        const bf16* QTb = (const bf16*)(ws + WS_CQT) + g0 * 256 + hh * 64;
        const bf16* ASb = (const bf16*)(ws + WS_CAS) + ((size_t)(bh * 64 + ch) * 32) * 32;
        const float* ECb = (const float*)(ws + WS_ECL) + (size_t)(b * 64 + ch) * 256 + hh * 64;
        bf16x8 va[4];
#pragma unroll
        for (int et = 0; et < 4; ++et) va[et] = ldg8(VTb + (16 * et + r) * 32 + 8 * q);
#pragma unroll
        for (int tt = 0; tt < 2; ++tt) {
            const bf16x8 bq0 = ldg8(QTb + (size_t)(16 * tt + r) * 256 + 8 * q), bq1 = ldg8(QTb + (size_t)(16 * tt + r) * 256 + 32 + 8 * q);
            const bf16x8 ba = ldg8(ASb + (16 * tt + r) * 32 + 8 * q);
            f32x4 o[4];
#pragma unroll
            for (int et = 0; et < 4; ++et) {
                f32x4 acc = {0.f, 0.f, 0.f, 0.f};
                acc = MFMA16(lds8(SsT + (16 * et + r) * 72 + 8 * q), bq0, acc);
                acc = MFMA16(lds8(SsT + (16 * et + r) * 72 + 32 + 8 * q), bq1, acc);
                acc = MFMA16(va[et], ba, acc);
                o[et] = acc;
            }
            const size_t g = g0 + 16 * tt + r;
            norm_gate_store(o, H + g * DINP + HC_G + hh * 64, ng, CC + g * DM + 512 + hh * 64, q);
        }
#pragma unroll
        for (int dt = 0; dt < 4; ++dt) {
            const float ec = ECb[16 * dt + r];
            const bf16x8 bk = ldg8(KDb + (16 * dt + r) * 32 + 8 * q);
#pragma unroll
            for (int et = 0; et < 4; ++et) st[et][dt] = MFMA16(va[et], bk, st[et][dt] * ec);
        }
        WAVE_SYNC();
#pragma unroll
        for (int et = 0; et < 4; ++et)
#pragma unroll
            for (int dt = 0; dt < 4; ++dt)
#pragma unroll
                for (int e = 0; e < 4; ++e) SsT[(16 * et + 4 * q + e) * 72 + 16 * dt + r] = f2bf(st[et][dt][e]);
        WAVE_SYNC();
    }
}

template <int DSA>
__device__ __forceinline__ void attn_item(const Args& a, int idx, int lane) {
    const int n = 15 - (idx >> 7), rem = idx & 127, b = rem >> 4, hh = (rem >> 2) & 3, rq = rem & 3;
    const int r = lane & 15, q = lane >> 4;
    unsigned char* ws = a.ws;
    const bf16* H = (const bf16*)(ws + WS_H);
    constexpr int NDS = DSA ? 2 : 3;
    const int tq0 = 128 * n + rq + 4 * r;
    const bf16* VT = (const bf16*)(ws + (DSA ? WS_DVT : WS_MVT)) + (size_t)(b * 4 + hh) * 64 * SEQ;
    bf16x8 qf[2][NDS];
#pragma unroll
    for (int qi = 0; qi < 2; ++qi) {
        const size_t g = (size_t)b * SEQ + tq0 + 64 * qi;
#pragma unroll
        for (int ds = 0; ds < NDS; ++ds)
            qf[qi][ds] = DSA ? ldg8(H + g * DINP + HD_Q + hh * 64 + 32 * ds + 8 * q) : ldg8((const bf16*)(ws + WS_MQ) + (g * 4 + hh) * 96 + 32 * ds + 8 * q);
    }
    f32x4 o[2][4];
#pragma unroll
    for (int qi = 0; qi < 2; ++qi)
#pragma unroll
        for (int et = 0; et < 4; ++et) o[qi][et] = (f32x4){0.f, 0.f, 0.f, 0.f};
    float mrun[2] = {-1e30f, -1e30f}, lrun[2] = {0.f, 0.f};
    const float sc = (DSA ? 0.125f : 0.10206207261596575f) * LOG2E;
    const float slope2 = exp2f(-2.f * (float)(hh + 1)) * LOG2E;
    const int nd = (n == 0) ? 4 : 8;
    const int ng = DSA ? (nd + (n >= 2 ? n - 1 : 0)) : 4 * (n + 1);
    for (int gi = 0; gi < ng; ++gi) {
        int p, rp;
        if (DSA) { if (gi < nd) { p = (n == 0 ? 0 : n - 1 + (gi >> 2)); rp = gi & 3; } else { p = gi - nd; rp = rq; } }
        else { p = gi >> 2; rp = gi & 3; }
        const int sa = 128 * p + rp + 4 * (8 * (r >> 2) + (r & 3));
        bf16x8 kf[2][NDS];
#pragma unroll
        for (int kt = 0; kt < 2; ++kt) {
            const size_t g = (size_t)b * SEQ + sa + 16 * kt;
#pragma unroll
            for (int ds = 0; ds < NDS; ++ds) {
                if (DSA) kf[kt][ds] = ldg8(H + g * DINP + HD_K + hh * 64 + 32 * ds + 8 * q);
                else kf[kt][ds] = (ds < 2) ? ldg8((const bf16*)(ws + WS_MKN) + (g * 4 + hh) * 64 + 32 * ds + 8 * q) : ldg8((const bf16*)(ws + WS_MKR) + g * 32 + 8 * q);
            }
        }
        bf16x8 vf[4];
#pragma unroll
        for (int et = 0; et < 4; ++et) vf[et] = ldg8(VT + (size_t)(16 * et + r) * SEQ + rp * 512 + 32 * p + 8 * q);
        const int sbase = 128 * p + rp + 4 * (8 * q);
#pragma unroll
        for (int qi = 0; qi < 2; ++qi) {
            f32x4 s[2];
#pragma unroll
            for (int kt = 0; kt < 2; ++kt) { f32x4 acc = {0.f, 0.f, 0.f, 0.f};
#pragma unroll
                for (int ds = 0; ds < NDS; ++ds) acc = MFMA16(kf[kt][ds], qf[qi][ds], acc);
                s[kt] = acc; }
            const int tq = tq0 + 64 * qi;
            float sv[8]; bool ok[8]; float mx = -1e30f;
#pragma unroll
            for (int j = 0; j < 8; ++j) {
                const int d = tq - (sbase + 4 * j);
                float val = s[j >> 2][j & 3] * sc;
                if (DSA) {
                    const int mult = (d <= 128 ? 1 : 0) + (((d & 3) == 0 && d <= 512) ? 1 : 0) + (((d & 15) == 0) ? 1 : 0);
                    ok[j] = (d >= 0) && (mult > 0);
                    val += -slope2 * (float)d + (mult == 3 ? 1.5849625007211562f : (mult == 2 ? 1.f : 0.f));
                } else ok[j] = (d >= 0);
                sv[j] = ok[j] ? val : -1e30f;
                mx = fmaxf(mx, sv[j]);
            }
            mx = fmaxf(mx, __shfl_xor(mx, 16)); mx = fmaxf(mx, __shfl_xor(mx, 32));
            const float mn = fmaxf(mrun[qi], mx), alpha = exp2f(mrun[qi] - mn);
            mrun[qi] = mn;
            float pv[8]; float rs = 0.f;
#pragma unroll
            for (int j = 0; j < 8; ++j) { pv[j] = ok[j] ? exp2f(sv[j] - mn) : 0.f; rs += pv[j]; }
            lrun[qi] = lrun[qi] * alpha + rs;
            union { bf16x8 v; unsigned w[4]; } pf;
            pf.w[0] = pk2(pv[0], pv[1]); pf.w[1] = pk2(pv[2], pv[3]); pf.w[2] = pk2(pv[4], pv[5]); pf.w[3] = pk2(pv[6], pv[7]);
#pragma unroll
            for (int et = 0; et < 4; ++et) { f32x4 acc = o[qi][et] * alpha; o[qi][et] = MFMA16(vf[et], pf.v, acc); }
        }
    }
    bf16* CC = (bf16*)(ws + WS_XB);
#pragma unroll
    for (int qi = 0; qi < 2; ++qi) {
        float lt = lrun[qi]; lt += __shfl_xor(lt, 16); lt += __shfl_xor(lt, 32);
        const float inv = 1.f / lt;
        bf16* dst = CC + ((size_t)b * SEQ + tq0 + 64 * qi) * DM + (DSA ? 768 : 256) + hh * 64;
#pragma unroll
        for (int et = 0; et < 4; ++et) { u32x2 w; w.x = pk2(o[qi][et][0] * inv, o[qi][et][1] * inv); w.y = pk2(o[qi][et][2] * inv, o[qi][et][3] * inv);
            *(u32x2*)(dst + 16 * et + 4 * q) = w; }
    }
}
#ifdef NO_A
#define DIS_A(x)
#else
#define DIS_A(x) x
#endif
#ifdef NO_B
#define DIS_B(x)
#else
#define DIS_B(x) x
#endif
#ifdef NO_C
#define DIS_C(x)
#else
#define DIS_C(x) x
#endif
#ifdef NO_D
#define DIS_D(x)
#else
#define DIS_D(x) x
#endif
#ifdef NO_E
#define DIS_E(x)
#else
#define DIS_E(x) x
#endif
#ifdef NO_F
#define DIS_F(x)
#else
#define DIS_F(x) x
#endif
#ifdef NO_G
#define DIS_G(x)
#else
#define DIS_G(x) x
#endif
#ifdef NO_H
#define DIS_H(x)
#else
#define DIS_H(x) x
#endif

constexpr int NPHASE = 17;
constexpr int NWAVES = 8;
#ifndef MK_SPLIT
#define MK_SPLIT 0
#endif

template <int ph>
__device__ __forceinline__ void run_phase(const Args& args, LAS unsigned char* lds, int tid, int lane, int wave, int G, int bx, int gw, int NGW) {
    unsigned char* ws = args.ws;
    unsigned* ctl = (unsigned*)(ws + WS_CTL);
    if constexpr (ph == 0) {
            convert_weights(args, 0, 0, lds, gw, NGW, wave, lane);
            const float* x = args.in[0]; bf16* xb = (bf16*)(ws + WS_XB);
            for (size_t i = (size_t)gw * 64 + lane; i < (size_t)MTOK * DM / 8; i += (size_t)NGW * 64) {
                const f32x4 v0 = ((const f32x4*)x)[2 * i], v1 = ((const f32x4*)x)[2 * i + 1];
                u32x4 o; o.x = pk2(v0.x, v0.y); o.y = pk2(v0.z, v0.w); o.z = pk2(v1.x, v1.y); o.w = pk2(v1.z, v1.w);
                ((u32x4*)xb)[i] = o;
            }
            if (bx == 0 && tid < 64) ctl[tid] = 0u;
        } else {
            constexpr int l = (ph - 1) >> 3, sub = (ph - 1) & 7;
            if constexpr (sub == 0) {
                pg8::Gemm g{(const pg8::bf16_t*)(ws + WS_XB), (const pg8::bf16_t*)(ws + WS_WIN), MTOK, DINP, DM};
                pg8::StaticOrder S; S.init(MTOK, DINP, G, bx);
                pg8::EpiBf16<0> E{(pg8::bf16_t*)(ws + WS_H), DINP};
                pg8::gemm_phase<pg8::EpiBf16<0>, pg8::StaticOrder, true, true>(lds, g, S, E);
            } else if constexpr (sub == 1) {
                constexpr int N_GDN = 1024, N_MLA = 512, N_HG = 512, N_DSA = 256, NIT = N_GDN + N_MLA + N_HG + N_DSA;
                for (int it = bx; it < NIT; it += G) {
                    if (it < N_GDN) { DIS_A(gdn_prep_item(args, l, it, lds, tid)); }
                    else if (it < N_GDN + N_MLA) { DIS_B(mla_prep_item(args, l, it - N_GDN, lds, tid)); }
                    else if (it < N_GDN + N_MLA + N_HG) { DIS_C(hgrn_prep_item(args, l, it - N_GDN - N_MLA, lds, tid)); }
                    else { DIS_D(dsa_prep_item(args, it - N_GDN - N_MLA - N_HG, lds, tid)); }
                }
            } else if constexpr (sub == 2) {
                if (wave == 0 && bx < 32) { DIS_E(gdn_scan(args, l, bx, lds, lane)); }
                else if (wave == 0 && bx < 64) { DIS_F(hgrn_scan(args, l, bx - 32, lds, lane)); }
                for (;;) {
                    int idx = 0;
                    if (lane == 0) idx = (int)atomicAdd(ctl + l, 1u);
                    idx = __builtin_amdgcn_readfirstlane(idx);
                    if (idx >= 4096) break;
                    if (idx < 2048) { DIS_G(attn_item<0>(args, idx, lane)); } else { DIS_H(attn_item<1>(args, idx - 2048, lane)); }
                }
            } else if constexpr (sub == 3) {
                pg8::Gemm g{(const pg8::bf16_t*)(ws + WS_XB), (const pg8::bf16_t*)(ws + WS_WOUT), MTOK, DM, DM};
                pg8::StaticOrder S; S.init(MTOK, DM, G, bx);
                pg8::EpiRes E{l == 0 ? args.in[0] : args.out, args.out, DM, ALPHA};
                pg8::gemm_phase<pg8::EpiRes, pg8::StaticOrder, true, true>(lds, g, S, E);
            } else if constexpr (sub == 4 || sub == 7) {
                const float* gg = args.in[sub == 4 ? 13 : 17] + l * DM; const float* bb = args.in[sub == 4 ? 14 : 18] + l * DM;
                for (int m = gw; m < MTOK; m += NGW) ln_row(args.out + (size_t)m * DM, args.out + (size_t)m * DM, (bf16*)(ws + WS_XB) + (size_t)m * DM, gg, bb, lane);
                if (sub == 4) convert_weights(args, l, 1, lds, gw, NGW, wave, lane);
                else if (l == 0) convert_weights(args, 1, 0, lds, gw, NGW, wave, lane);
            } else if constexpr (sub == 5) {
                pg8::Gemm g{(const pg8::bf16_t*)(ws + WS_XB), (const pg8::bf16_t*)(ws + WS_W1), MTOK, DFF, DM};
                pg8::StaticOrder S; S.init(MTOK, DFF, G, bx);
                pg8::EpiBf16<2> E{(pg8::bf16_t*)(ws + WS_H), DFF};
                pg8::gemm_phase<pg8::EpiBf16<2>, pg8::StaticOrder, true, true>(lds, g, S, E);
            } else {
                pg8::Gemm g{(const pg8::bf16_t*)(ws + WS_H), (const pg8::bf16_t*)(ws + WS_W2), MTOK, DM, DFF};
                pg8::StaticOrder S; S.init(MTOK, DM, G, bx);
                pg8::EpiRes E{args.out, args.out, DM, ALPHA};
                pg8::gemm_phase<pg8::EpiRes, pg8::StaticOrder, true, true>(lds, g, S, E);
            }
        }
}

__global__ void __launch_bounds__(NWAVES * 64, 2) hybrid_fwd(Args args) {
    extern __shared__ __attribute__((aligned(16))) unsigned char lds_raw[];
    LAS unsigned char* lds = (LAS unsigned char*)lds_raw;
    const int tid = threadIdx.x, lane = tid & 63, wave = __builtin_amdgcn_readfirstlane(tid >> 6);
    const int G = gridDim.x, bx = blockIdx.x;
    const int gw = bx * NWAVES + wave, NGW = G * NWAVES;
    cg::grid_group grid = cg::this_grid();
    const int lo = args.ph_lo, hi = args.ph_hi;
#define PHASE(k) if (lo <= (k) && (k) < hi) { run_phase<k>(args, lds, tid, lane, wave, G, bx, gw, NGW); if ((k) + 1 < hi) grid.sync(); }
    PHASE(0) PHASE(1) PHASE(2) PHASE(3) PHASE(4) PHASE(5) PHASE(6) PHASE(7) PHASE(8)
    PHASE(9) PHASE(10) PHASE(11) PHASE(12) PHASE(13) PHASE(14) PHASE(15) PHASE(16)
#undef PHASE
}

extern "C" void kernel_launch(void* const* d_in, const int* in_sizes, int n_in, void* d_out, int out_size, void* d_ws, size_t ws_size, hipStream_t stream) {
    static int grid = 0;
    if (grid == 0) {
        if (n_in != 19 || in_sizes[0] != MTOK * DM || out_size != MTOK * DM || ws_size < WS_END) {
            fprintf(stderr, "kernel_launch: unexpected shapes (n_in %d, in0 %d, out %d, ws %zu)\n", n_in, n_in > 0 ? in_sizes[0] : -1, out_size, ws_size); grid = -1; return; }
        int dev = 0, cus = 0, per_cu = 0;
        hipGetDevice(&dev); hipDeviceGetAttribute(&cus, hipDeviceAttributeMultiprocessorCount, dev);
        hipFuncSetAttribute((const void*)hybrid_fwd, hipFuncAttributeMaxDynamicSharedMemorySize, LDS_BYTES);
        hipOccupancyMaxActiveBlocksPerMultiprocessor(&per_cu, (const void*)hybrid_fwd, NWAVES * 64, LDS_BYTES);
        if (per_cu < 1) { fprintf(stderr, "kernel_launch: occupancy query says %d blocks per CU\n", per_cu); per_cu = 1; }
        (void)hipGetLastError();
        grid = cus * 1;
    }
    if (grid < 0) return;
    Args a{};
    for (int i = 0; i < 19; ++i) a.in[i] = (const float*)d_in[i];
    a.out = (float*)d_out; a.ws = (unsigned char*)d_ws;
#if MK_SPLIT
    for (int ph = 0; ph < NPHASE; ++ph) { a.ph_lo = ph; a.ph_hi = ph + 1; hipLaunchKernelGGL(hybrid_fwd, dim3(grid), dim3(NWAVES * 64), LDS_BYTES, stream, a); }
#else
    a.ph_lo = 0; a.ph_hi = NPHASE;
    void* kargs[] = {&a};
    hipError_t e = hipLaunchCooperativeKernel((const void*)hybrid_fwd, dim3(grid), dim3(NWAVES * 64), kargs, LDS_BYTES, stream);
    if (e != hipSuccess) fprintf(stderr, "cooperative launch failed: %s (grid %d)\n", hipGetErrorString(e), grid);
#endif
}
```

```cpp
#include <hip/hip_runtime.h>
#include <hip/hip_cooperative_groups.h>
#include <cstdio>
#include <cstdint>
namespace cg = cooperative_groups;
namespace pg8 {
#define PG8_LAS __attribute__((address_space(3)))
typedef unsigned short bf16_t;
typedef short bf16x8 __attribute__((ext_vector_type(8)));
typedef float f32x4 __attribute__((ext_vector_type(4)));
typedef unsigned u32x4 __attribute__((ext_vector_type(4)));
constexpr int BM = 256, BK = 64, HALF = 128, HTB = HALF * BK * 2  , STAGE_BYTES = 8 * HTB, NXCD = 8, WGM = 8;

__host__ __device__ __forceinline__ int lds_byte(int r, int c) { const int st = (r >> 4) * 2 + (c >> 5), rr = r & 15, cc = c & 31, ob = rr * 64 + cc * 2; return st * 1024 + (ob ^ (((ob >> 9) & 1) << 5)); }
__host__ __device__ __forceinline__ void stage_rc(int b, int& R, int& C) { const int st = b / 1024, sb = b % 1024, swz = sb ^ (((sb >> 9) & 1) << 5); R = (st >> 1) * 16 + swz / 64; C = (st & 1) * 32 + (swz % 64) / 2; }
__host__ __device__ __forceinline__ int perm32(int rho) { const int n = rho >> 4, i = rho & 15; return 8 * (i >> 2) + 4 * n + (i & 3); }

struct Unit { int pm, pn; };
struct Gemm { const bf16_t* A; const bf16_t* Bt; int M, N, K; };

struct StaticOrder {
    int nM, nN, nwg, G, c;
    __host__ __device__ void init(int M, int N, int G_, int c_) { nM = M / BM; nN = N / BM; nwg = nM * nN; G = G_; c = c_; }
    __host__ __device__ bool next(int i, Unit& u) const {
        const long L = (long)i * G + c; if (L >= nwg) return false;
        int wgid = (int)L; { const int q = nwg / NXCD, r = nwg % NXCD, xcd = wgid % NXCD, off = wgid / NXCD; wgid = (xcd < r ? xcd * (q + 1) : r * (q + 1) + (xcd - r) * q) + off; }
        const int nig = WGM * nN, gid = wgid / nig, fm = gid * WGM, gsz = (nM - fm) < WGM ? (nM - fm) : WGM;
        u.pm = fm + ((wgid % nig) % gsz); u.pn = (wgid % nig) / gsz; return true;
    }
    __device__ __forceinline__ void a_ready(const Unit&) const {}
    __device__ __forceinline__ void done(const Unit&) const {}
};

__device__ __forceinline__ unsigned cvt_pk_bf16(float lo, float hi) { unsigned r; asm volatile("v_cvt_pk_bf16_f32 %0, %1, %2" : "=v"(r) : "v"(lo), "v"(hi)); return r; }
template <int ACT  > struct EpiBf16 {
    static constexpr bool PERM = true, AFTER_DRAIN = false;
    bf16_t* O; int ldc;
    __device__ __forceinline__ void operator()(const f32x4 (&acc)[2][2][4][2], const Unit& u, int wr, int wc, int fr, int fq) const {
        const int row0 = u.pm * BM + wr * 64 + fr; const int col0 = u.pn * BM + wc * 32 + 8 * fq;
#pragma unroll
        for (int ai = 0; ai < 2; ++ai)
#pragma unroll
            for (int m = 0; m < 4; ++m) { bf16_t* rowp = O + (size_t)(row0 + ai * HALF + m * 16) * ldc + col0;
#pragma unroll
                for (int bj = 0; bj < 2; ++bj) { f32x4 v0 = acc[ai][bj][m][0], v1 = acc[ai][bj][m][1];
                    if (ACT == 2) {
#pragma unroll
                        for (int e = 0; e < 4; ++e) { float a = v0[e] > 0.f ? v0[e] : 0.f; v0[e] = a * a; float b = v1[e] > 0.f ? v1[e] : 0.f; v1[e] = b * b; } }
                    u32x4 w; w.x = cvt_pk_bf16(v0[0], v0[1]); w.y = cvt_pk_bf16(v0[2], v0[3]); w.z = cvt_pk_bf16(v1[0], v1[1]); w.w = cvt_pk_bf16(v1[2], v1[3]);
                    *(u32x4*)(rowp + bj * HALF) = w; } }
    }
};
struct EpiRes {
    static constexpr bool PERM = false, AFTER_DRAIN = false;
    const float* base; float* out; int ldc; float alpha;
    __device__ __forceinline__ void operator()(const f32x4 (&acc)[2][2][4][2], const Unit& u, int wr, int wc, int fr, int fq) const {
        const int col0 = u.pn * BM + wc * 32 + 4 * fq;
#pragma unroll
        for (int ai = 0; ai < 2; ++ai)
#pragma unroll
            for (int m = 0; m < 4; ++m) { const size_t off = (size_t)(u.pm * BM + ai * HALF + wr * 64 + m * 16 + fr) * ldc + col0;
#pragma unroll
                for (int bj = 0; bj < 2; ++bj)
#pragma unroll
                    for (int n = 0; n < 2; ++n) { const f32x4 bs = *(const f32x4*)(base + off + bj * HALF + n * 16);
                        *(f32x4*)(out + off + bj * HALF + n * 16) = bs * alpha + acc[ai][bj][m][n]; }
                asm volatile("" ::: "memory"); }
    }
};
template <class Epi, class Sched, bool ALIGN_EPI = false, bool SP2 = false>
__device__ __forceinline__ void gemm_phase(PG8_LAS unsigned char* lds, const Gemm g, const Sched& S, const Epi& E) {
    const int tid = threadIdx.x, wid = __builtin_amdgcn_readfirstlane(tid >> 6), lane = tid & 63, wr = wid >> 2, wc = wid & 3, fr = lane & 15, fq = lane >> 4;
    const int K = g.K, nt = K / BK;
    unsigned voffA[2], voffB[2];
#pragma unroll
    for (int i = 0; i < 2; ++i) { int R, C; stage_rc(tid * 16 + i * 8192, R, C); const int Rb = Epi::PERM ? ((R & ~31) + perm32(R & 31)) : R;
        voffA[i] = (unsigned)(R * K + C) * 2u; voffB[i] = (unsigned)(Rb * K + C) * 2u; }
    const size_t kstep = (size_t)(BK * 2);
    const size_t hstep = (size_t)HALF * K * 2;
    const size_t tstep = 2 * hstep;
    const unsigned ldsw = (unsigned)wid * 1024u;
    const int aoff = lds_byte(wr * 64 + fr, fq * 8), boff = lds_byte(wc * 32 + fr, fq * 8);
#define PG8_SA(b, h) (((b) * 2 + (h)) * HTB)
#define PG8_SB(b, h) ((4 + (b) * 2 + (h)) * HTB)
#define PG8_STAGE(bufoff, gbase, voff) do { _Pragma("unroll") for (int _i = 0; _i < 2; ++_i) \
        __builtin_amdgcn_global_load_lds((const unsigned*)((const char*)(gbase) + (voff)[_i]), (PG8_LAS unsigned*)(lds + (bufoff) + ldsw + _i * 8192), 16, 0, 0); } while (0)
#define PG8_LDA(dst, b, h) do { _Pragma("unroll") for (int m = 0; m < 4; ++m) _Pragma("unroll") for (int k = 0; k < 2; ++k) dst[m][k] = *(const PG8_LAS bf16x8*)(lds + PG8_SA(b, h) + aoff + m * 2048 + k * 1024); } while (0)
#define PG8_LDB(dst, b, h) do { _Pragma("unroll") for (int n = 0; n < 2; ++n) _Pragma("unroll") for (int k = 0; k < 2; ++k) dst[n][k] = *(const PG8_LAS bf16x8*)(lds + PG8_SB(b, h) + boff + n * 2048 + k * 1024); } while (0)
#define PG8_MMA(ai, bj, At, Bt) do { __builtin_amdgcn_s_setprio(1); _Pragma("unroll") for (int m = 0; m < 4; ++m) _Pragma("unroll") for (int n = 0; n < 2; ++n) _Pragma("unroll") for (int k = 0; k < 2; ++k) \
        acc[ai][bj][m][n] = __builtin_amdgcn_mfma_f32_16x16x32_bf16(Bt[n][k], At[m][k], acc[ai][bj][m][n], 0, 0, 0); __builtin_amdgcn_s_setprio(0); } while (0)
#define PG8_WAIT_V(n) asm volatile("s_waitcnt vmcnt(" #n ")" ::: "memory")
#define PG8_WAIT_L(n) asm volatile("s_waitcnt lgkmcnt(" #n ")" ::: "memory")
#define PG8_BAR __builtin_amdgcn_s_barrier()
#define PG8_SCHED __builtin_amdgcn_sched_barrier(0)
    Unit cur, nxt; int ui = 0;
    if (!S.next(0, cur)) return;
    f32x4 acc[2][2][4][2];
#pragma unroll
    for (int a = 0; a < 2; ++a)
#pragma unroll
        for (int b = 0; b < 2; ++b)
#pragma unroll
            for (int m = 0; m < 4; ++m)
#pragma unroll
                for (int n = 0; n < 2; ++n) acc[a][b][m][n] = (f32x4){0.f, 0.f, 0.f, 0.f};
    bf16x8 At[4][2], B0[2][2], B1[2][2];
    const char* cA = (const char*)g.A + (size_t)cur.pm * tstep; const char* cB = (const char*)g.Bt + (size_t)cur.pn * tstep;
    S.a_ready(cur);
    if constexpr (SP2) {
        PG8_STAGE(PG8_SB(0, 0), cB, voffB); PG8_STAGE(PG8_SB(0, 1), cB + hstep, voffB); PG8_STAGE(PG8_SA(0, 0), cA, voffA); PG8_STAGE(PG8_SA(0, 1), cA + hstep, voffA);
        if (wr == 1) PG8_BAR;
        PG8_WAIT_V(2); PG8_BAR;
        PG8_STAGE(PG8_SB(1, 0), cB + kstep, voffB); PG8_STAGE(PG8_SA(1, 0), cA + kstep, voffA); PG8_STAGE(PG8_SB(1, 1), cB + hstep + kstep, voffB);
        PG8_WAIT_V(6); PG8_BAR;
    } else {
        PG8_STAGE(PG8_SB(0, 0), cB, voffB); PG8_STAGE(PG8_SA(0, 0), cA, voffA); PG8_STAGE(PG8_SB(0, 1), cB + hstep, voffB); PG8_STAGE(PG8_SA(0, 1), cA + hstep, voffA);
        if (wr == 1) PG8_BAR;
        PG8_WAIT_V(4); PG8_BAR;
        PG8_STAGE(PG8_SB(1, 0), cB + kstep, voffB); PG8_STAGE(PG8_SA(1, 0), cA + kstep, voffA); PG8_STAGE(PG8_SB(1, 1), cB + hstep + kstep, voffB);
        PG8_WAIT_V(6); PG8_BAR;
    }
    for (;;) {
        const bool has_next = S.next(ui + 1, nxt);
        const char* nA = has_next ? (const char*)g.A + (size_t)nxt.pm * tstep : cA; const char* nB = has_next ? (const char*)g.Bt + (size_t)nxt.pn * tstep : cB;
        for (int t = 0; t < nt; t += 2) {
            const bool last = (t == nt - 2);
            const char* a1 = cA + (size_t)(t + 1) * kstep;
            const char* a2 = last ? nA : cA + (size_t)(t + 2) * kstep; const char* b2 = last ? nB : cB + (size_t)(t + 2) * kstep;
            const char* a3 = a2 + kstep; const char* b3 = b2 + kstep;
            if (last && has_next) S.a_ready(nxt);
            if constexpr (SP2) {
            PG8_LDB(B0, 0, 0); PG8_LDB(B1, 0, 1); PG8_SCHED; PG8_LDA(At, 0, 0); PG8_STAGE(PG8_SA(1, 1), a1 + hstep, voffA);
            PG8_WAIT_V(8); PG8_WAIT_L(0); PG8_BAR; PG8_MMA(0, 0, At, B0); PG8_MMA(0, 1, At, B1); PG8_BAR; PG8_SCHED;
            PG8_LDA(At, 0, 1); PG8_STAGE(PG8_SB(0, 0), b2, voffB); PG8_STAGE(PG8_SB(0, 1), b2 + hstep, voffB); PG8_STAGE(PG8_SA(0, 0), a2, voffA);
            PG8_WAIT_V(8); PG8_WAIT_L(0); PG8_BAR; PG8_MMA(1, 0, At, B0); PG8_MMA(1, 1, At, B1); PG8_BAR; PG8_SCHED;
            PG8_LDB(B0, 1, 0); PG8_LDB(B1, 1, 1); PG8_SCHED; PG8_LDA(At, 1, 0); PG8_STAGE(PG8_SA(0, 1), a2 + hstep, voffA);
            PG8_WAIT_V(8); PG8_WAIT_L(0); PG8_BAR; PG8_MMA(0, 0, At, B0); PG8_MMA(0, 1, At, B1); PG8_BAR; PG8_SCHED;
            PG8_LDA(At, 1, 1); PG8_STAGE(PG8_SB(1, 0), b3, voffB); PG8_STAGE(PG8_SB(1, 1), b3 + hstep, voffB); PG8_STAGE(PG8_SA(1, 0), a3, voffA);
            PG8_WAIT_V(8); PG8_WAIT_L(0); PG8_BAR; PG8_MMA(1, 0, At, B0); PG8_MMA(1, 1, At, B1); PG8_BAR; PG8_SCHED;
            } else {
            PG8_LDB(B0, 0, 0); PG8_SCHED; PG8_LDA(At, 0, 0); PG8_STAGE(PG8_SA(1, 1), a1 + hstep, voffA);
            PG8_WAIT_L(8); PG8_BAR; PG8_WAIT_L(0); PG8_MMA(0, 0, At, B0); PG8_BAR; PG8_SCHED;
            PG8_LDB(B1, 0, 1); PG8_STAGE(PG8_SB(0, 0), b2, voffB);
            PG8_BAR; PG8_WAIT_L(0); PG8_MMA(0, 1, At, B1); PG8_BAR;
            PG8_LDA(At, 0, 1); PG8_STAGE(PG8_SA(0, 0), a2, voffA);
            PG8_BAR; PG8_WAIT_L(0); PG8_MMA(1, 0, At, B0); PG8_BAR; PG8_SCHED;
            PG8_STAGE(PG8_SB(0, 1), b2 + hstep, voffB);
            PG8_WAIT_V(6); PG8_BAR; PG8_MMA(1, 1, At, B1); PG8_BAR;
            PG8_LDB(B0, 1, 0); PG8_SCHED; PG8_LDA(At, 1, 0); PG8_STAGE(PG8_SA(0, 1), a2 + hstep, voffA);
            PG8_WAIT_L(8); PG8_BAR; PG8_WAIT_L(0); PG8_MMA(0, 0, At, B0); PG8_BAR; PG8_SCHED;
            PG8_LDB(B1, 1, 1); PG8_STAGE(PG8_SB(1, 0), b3, voffB);
            PG8_BAR; PG8_WAIT_L(0); PG8_MMA(0, 1, At, B1); PG8_BAR;
            PG8_LDA(At, 1, 1); PG8_STAGE(PG8_SA(1, 0), a3, voffA);
            PG8_BAR; PG8_WAIT_L(0); PG8_MMA(1, 0, At, B0); PG8_BAR; PG8_SCHED;
            PG8_STAGE(PG8_SB(1, 1), b3 + hstep, voffB);
            PG8_WAIT_V(6); PG8_BAR; PG8_MMA(1, 1, At, B1); PG8_BAR;
            }
        }
        if constexpr (ALIGN_EPI) { if (wr == 0) PG8_BAR; }
        if constexpr (!Epi::AFTER_DRAIN) { E(acc, cur, wr, wc, fr, fq); S.done(cur); }
        if (!has_next) break;
#pragma unroll
        for (int a = 0; a < 2; ++a)
#pragma unroll
            for (int b = 0; b < 2; ++b)
#pragma unroll
                for (int m = 0; m < 4; ++m)
#pragma unroll
                    for (int n = 0; n < 2; ++n) acc[a][b][m][n] = (f32x4){0.f, 0.f, 0.f, 0.f};
        cur = nxt; cA = nA; cB = nB; ++ui;
        if constexpr (ALIGN_EPI) { if (wr == 1) PG8_BAR; }
    }
    PG8_WAIT_V(0);
    if constexpr (!ALIGN_EPI) { if (wr == 0) PG8_BAR; }
    PG8_BAR;
    if constexpr (Epi::AFTER_DRAIN) { E.fused(acc, cur, wr, wc, fr, fq, lds, wid, lane); S.done(cur); }
#undef PG8_SA
#undef PG8_SB
#undef PG8_STAGE
#undef PG8_LDA
#undef PG8_LDB
#undef PG8_MMA
#undef PG8_WAIT_V
#undef PG8_WAIT_L
#undef PG8_BAR
#undef PG8_SCHED
}
}

#define LAS __attribute__((address_space(3)))
typedef unsigned short bf16;
typedef short bf16x8 __attribute__((ext_vector_type(8)));
typedef float f32x4 __attribute__((ext_vector_type(4)));
typedef unsigned u32x4 __attribute__((ext_vector_type(4)));
typedef unsigned u32x2 __attribute__((ext_vector_type(2)));

constexpr int NB = 8, SEQ = 2048, DM = 1024, MTOK = NB * SEQ, DIN = 3176, DINP = 3328, DFF = 4096;
constexpr int HA_Q = 0, HA_K = 256, HA_V = 512, HA_A = 768, HA_B = 772, HA_Z = 776;
constexpr int HB_CQ = 1032, HB_CKV = 1224, HB_KR = 1352;
constexpr int HC_Q = 1384, HC_F = 1640, HC_I = 1896, HC_G = 2152;
constexpr int HD_Q = 2408, HD_K = 2664, HD_V = 2920;
constexpr float ALPHA = 1.4142135623730951f, EPS = 1e-6f, LOG2E = 1.4426950408889634f;

constexpr size_t MiB = 1u << 20;
constexpr size_t WS_CTL = 0;
constexpr size_t WS_WIN = 1 * MiB;
constexpr size_t WS_WOUT = WS_WIN + 6656 * 1024;
constexpr size_t WS_WUQ = WS_WOUT + 2 * MiB;
constexpr size_t WS_WUKV = WS_WUQ + 256 * 1024;
constexpr size_t WS_XB = 10 * MiB;
constexpr size_t WS_H = 42 * MiB;
constexpr size_t WS_T = 146 * MiB;
constexpr size_t WS_CVT = WS_T;
constexpr size_t WS_CAS = WS_T + 8 * MiB;
constexpr size_t WS_DVT = WS_T + 12 * MiB;
constexpr size_t WS_EGL = WS_T + 20 * MiB;
constexpr size_t WS_ECL = WS_T + 21 * MiB;
constexpr size_t WS_X2 = 170 * MiB;
constexpr size_t WS_W1 = WS_X2;
constexpr size_t WS_W2 = WS_X2 + 8 * MiB;
constexpr size_t WS_GU = WS_X2;
constexpr size_t WS_GW = WS_X2 + 8 * MiB;
constexpr size_t WS_GQD = WS_X2 + 16 * MiB;
constexpr size_t WS_GKDT = WS_X2 + 24 * MiB;
constexpr size_t WS_GQK = WS_X2 + 32 * MiB;
constexpr size_t WS_MQ = WS_X2 + 40 * MiB;
constexpr size_t WS_MKN = WS_X2 + 52 * MiB;
constexpr size_t WS_MKR = WS_X2 + 60 * MiB;
constexpr size_t WS_MVT = WS_X2 + 61 * MiB;
constexpr size_t WS_CQT = WS_X2 + 69 * MiB;
constexpr size_t WS_CKDT = WS_X2 + 77 * MiB;
constexpr size_t WS_END = 256 * MiB;

constexpr int LDS_BYTES = 131072 + 1024;

__device__ __forceinline__ float bf2f(unsigned short h) { return __uint_as_float(((unsigned)h) << 16); }
__device__ __forceinline__ unsigned short f2bf(float f) { unsigned u = __float_as_uint(f); return (unsigned short)((u + 0x7fffu + ((u >> 16) & 1u)) >> 16); }
__device__ __forceinline__ unsigned pk2(float lo, float hi) { return (unsigned)f2bf(lo) | ((unsigned)f2bf(hi) << 16); }
__device__ __forceinline__ float bfw(unsigned w, int hi) { return hi ? __uint_as_float(w & 0xffff0000u) : __uint_as_float(w << 16); }
__device__ __forceinline__ float sigmoidf_(float x) { return 1.f / (1.f + __expf(-x)); }
__device__ __forceinline__ float siluf_(float x) { return x / (1.f + __expf(-x)); }
#define MFMA16(a, b, c) __builtin_amdgcn_mfma_f32_16x16x32_bf16((a), (b), (c), 0, 0, 0)
#define WAVE_SYNC() asm volatile("s_waitcnt lgkmcnt(0)" ::: "memory")
__device__ __forceinline__ bf16x8 ldg8(const bf16* p) { return *(const bf16x8*)p; }
__device__ __forceinline__ bf16x8 lds8(const LAS bf16* p) { return *(const LAS bf16x8*)p; }

struct Args { const float* in[19]; float* out; unsigned char* ws; int ph_lo, ph_hi; };

__device__ __forceinline__ void tr_item(const float* __restrict__ W, int K, int N, bf16* __restrict__ WT, LAS float* scr, int item, int lane) {
    const int nblk = (N + 31) >> 5, kb = item / nblk, nb = item - kb * nblk, k0 = 64 * kb, n0 = 32 * nb;
    const int n = n0 + (lane & 31);
#pragma unroll 8
    for (int i = 0; i < 32; ++i) { const int kk = 2 * i + (lane >> 5); scr[kk * 33 + (lane & 31)] = (n < N) ? W[(size_t)(k0 + kk) * N + n] : 0.f; }
    WAVE_SYNC();
    const int c = lane & 7;
#pragma unroll
    for (int j = 0; j < 4; ++j) { const int nn = (lane >> 3) + 8 * j; const LAS float* s = scr + (8 * c) * 33 + nn;
        u32x4 o; o.x = pk2(s[0 * 33], s[1 * 33]); o.y = pk2(s[2 * 33], s[3 * 33]); o.z = pk2(s[4 * 33], s[5 * 33]); o.w = pk2(s[6 * 33], s[7 * 33]);
        *(u32x4*)(WT + (size_t)(n0 + nn) * K + k0 + 8 * c) = o; }
    WAVE_SYNC();
}
__device__ __forceinline__ float wave_sum(float v) {
#pragma unroll
    for (int o = 1; o < 64; o <<= 1) v += __shfl_xor(v, o);
    return v;
}
__device__ __forceinline__ void convert_weights(const Args& a, int l, int which, LAS unsigned char* lds, int gw, int NGW, int wave, int lane) {
    LAS float* scr = (LAS float*)(lds + wave * 16384);
    unsigned char* ws = a.ws;
    if (which == 0) {
        constexpr int I_IN = 16 * 100, I_OUT = 16 * 32, I_UQ = 3 * 12, I_UKV = 2 * 16, NIT = I_IN + I_OUT + I_UQ + I_UKV;
        for (int it = gw; it < NIT; it += NGW) {
            int r = it;
            if (r < I_IN) { tr_item(a.in[1] + (size_t)l * DM * DIN, DM, DIN, (bf16*)(ws + WS_WIN), scr, r, lane); continue; } r -= I_IN;
            if (r < I_OUT) { tr_item(a.in[12] + (size_t)l * DM * DM, DM, DM, (bf16*)(ws + WS_WOUT), scr, r, lane); continue; } r -= I_OUT;
            if (r < I_UQ) { tr_item(a.in[8] + (size_t)l * 192 * 384, 192, 384, (bf16*)(ws + WS_WUQ), scr, r, lane); continue; } r -= I_UQ;
            tr_item(a.in[9] + (size_t)l * 128 * 512, 128, 512, (bf16*)(ws + WS_WUKV), scr, r, lane);
        }
        u32x4 z = {0u, 0u, 0u, 0u};
        for (int i = gw * 64 + lane; i < 16384; i += NGW * 64) *(u32x4*)(ws + WS_WIN + (size_t)3200 * 2048 + (size_t)i * 16) = z;
    } else {
        constexpr int I_1 = 16 * 128, I_2 = 64 * 32, NIT = I_1 + I_2;
        for (int it = gw; it < NIT; it += NGW) {
            if (it < I_1) tr_item(a.in[15] + (size_t)l * DM * DFF, DM, DFF, (bf16*)(ws + WS_W1), scr, it, lane);
            else tr_item(a.in[16] + (size_t)l * DFF * DM, DFF, DM, (bf16*)(ws + WS_W2), scr, it - I_1, lane);
        }
    }
}
__device__ __forceinline__ void ln_row(const float* yrow, float* xo, bf16* xb, const float* g, const float* bb, int lane) {
    const f32x4* yr = (const f32x4*)yrow + lane;
    f32x4 v[4]; float s = 0.f;
#pragma unroll
    for (int j = 0; j < 4; ++j) { v[j] = yr[64 * j]; s += (v[j].x + v[j].y) + (v[j].z + v[j].w); }
    const float mean = wave_sum(s) * (1.f / DM); float s2 = 0.f;
#pragma unroll
    for (int j = 0; j < 4; ++j) { v[j] = v[j] - mean; s2 += (v[j].x * v[j].x + v[j].y * v[j].y) + (v[j].z * v[j].z + v[j].w * v[j].w); }
    const float rstd = 1.f / sqrtf(wave_sum(s2) * (1.f / DM) + EPS);
#pragma unroll
    for (int j = 0; j < 4; ++j) { const f32x4 gg = ((const f32x4*)g)[lane + 64 * j], b4 = ((const f32x4*)bb)[lane + 64 * j];
        f32x4 o = v[j] * rstd * gg + b4;
        ((f32x4*)xo)[lane + 64 * j] = o;
        u32x2 w; w.x = pk2(o.x, o.y); w.y = pk2(o.z, o.w); ((u32x2*)xb)[lane + 64 * j] = w; }
}

__device__ __forceinline__ void gdn_prep_item(const Args& a, int l, int item, LAS unsigned char* lds, int tid) {
    const int bh = item >> 5, n = item & 31, b = bh >> 2, hh = bh & 3, t0 = n * 64;
    const int lane = tid & 63, wave = tid >> 6, r = lane & 15, q = lane >> 4;
    unsigned char* ws = a.ws;
    const bf16* H = (const bf16*)(ws + WS_H);
    LAS bf16* Kb = (LAS bf16*)lds;
    LAS bf16* Qb = Kb + 64 * 72;
    LAS bf16* Vb = Qb + 64 * 72;
    LAS float* Lm = (LAS float*)(lds + 27648);
    LAS float* gcs = (LAS float*)(lds + 27648 + 16384);
    LAS float* bet = gcs + 64;
    {
        const int tok = tid >> 3, seg = tid & 7, t = t0 + tok;
        float qa[8], ka[8], va[8];
#pragma unroll
        for (int e = 0; e < 8; ++e) { qa[e] = 0.f; ka[e] = 0.f; va[e] = 0.f; }
        const float* cw = a.in[2] + (size_t)l * 4 * 768;
#pragma unroll
        for (int j = 0; j < 4; ++j) {
            const int tt = t - 3 + j;
            if (tt >= 0) {
                const bf16* row = H + (size_t)(b * SEQ + tt) * DINP;
                const u32x4 xq = *(const u32x4*)(row + HA_Q + hh * 64 + seg * 8);
                const u32x4 xk = *(const u32x4*)(row + HA_K + hh * 64 + seg * 8);
                const u32x4 xv = *(const u32x4*)(row + HA_V + hh * 64 + seg * 8);
                const float* wq = cw + j * 768 + HA_Q + hh * 64 + seg * 8;
                const float* wk = cw + j * 768 + HA_K + hh * 64 + seg * 8;
                const float* wv = cw + j * 768 + HA_V + hh * 64 + seg * 8;
#pragma unroll
                for (int e = 0; e < 8; ++e) {
                    qa[e] += wq[e] * bfw(xq[e >> 1], e & 1);
                    ka[e] += wk[e] * bfw(xk[e >> 1], e & 1);
                    va[e] += wv[e] * bfw(xv[e >> 1], e & 1);
                }
            }
        }
        float sq = 0.f, sk = 0.f;
#pragma unroll
        for (int e = 0; e < 8; ++e) { qa[e] = siluf_(qa[e]); ka[e] = siluf_(ka[e]); va[e] = siluf_(va[e]); sq += qa[e] * qa[e]; sk += ka[e] * ka[e]; }
        sq += __shfl_xor(sq, 1); sq += __shfl_xor(sq, 2); sq += __shfl_xor(sq, 4);
        sk += __shfl_xor(sk, 1); sk += __shfl_xor(sk, 2); sk += __shfl_xor(sk, 4);
        const float rq = rsqrtf(sq + EPS) * 0.125f, rk = rsqrtf(sk + EPS);
        u32x4 oq, ok, ov;
        oq.x = pk2(qa[0] * rq, qa[1] * rq); oq.y = pk2(qa[2] * rq, qa[3] * rq); oq.z = pk2(qa[4] * rq, qa[5] * rq); oq.w = pk2(qa[6] * rq, qa[7] * rq);
        ok.x = pk2(ka[0] * rk, ka[1] * rk); ok.y = pk2(ka[2] * rk, ka[3] * rk); ok.z = pk2(ka[4] * rk, ka[5] * rk); ok.w = pk2(ka[6] * rk, ka[7] * rk);
        ov.x = pk2(va[0], va[1]); ov.y = pk2(va[2], va[3]); ov.z = pk2(va[4], va[5]); ov.w = pk2(va[6], va[7]);
        *(LAS u32x4*)(Qb + tok * 72 + seg * 8) = oq;
        *(LAS u32x4*)(Kb + tok * 72 + seg * 8) = ok;
        *(LAS u32x4*)(Vb + tok * 72 + seg * 8) = ov;
        if (seg == 0) {
            const bf16* row = H + (size_t)(b * SEQ + t) * DINP;
            const float av = bf2f(row[HA_A + hh]), bv = bf2f(row[HA_B + hh]);
            const float xs = av + a.in[4][l * 4 + hh];
            const float sp = xs > 20.f ? xs : log1pf(__expf(xs));
            gcs[tok] = -__expf(a.in[3][l * 4 + hh]) * sp;
            bet[tok] = sigmoidf_(bv);
        }
    }
    __syncthreads();
    if (wave == 0) {
        float v = gcs[lane];
#pragma unroll
        for (int o = 1; o < 64; o <<= 1) { const float t = __shfl_up(v, o); if (lane >= o) v += t; }
        gcs[lane] = v;
    }
    __syncthreads();
    {
        const int it = wave >> 1, jt0 = (wave & 1) * 2;
        bf16* QKg = (bf16*)(ws + WS_GQK) + (size_t)(bh * 32 + n) * 4096;
        bf16x8 ak[2], aq[2];
#pragma unroll
        for (int ks = 0; ks < 2; ++ks) { ak[ks] = lds8(Kb + (16 * it + r) * 72 + 32 * ks + 8 * q); aq[ks] = lds8(Qb + (16 * it + r) * 72 + 32 * ks + 8 * q); }
#pragma unroll
        for (int jj2 = 0; jj2 < 2; ++jj2) {
            const int jt = jt0 + jj2;
            f32x4 ckk = {0.f, 0.f, 0.f, 0.f}, cqk = {0.f, 0.f, 0.f, 0.f};
#pragma unroll
            for (int ks = 0; ks < 2; ++ks) { const bf16x8 bk = lds8(Kb + (16 * jt + r) * 72 + 32 * ks + 8 * q); ckk = MFMA16(ak[ks], bk, ckk); cqk = MFMA16(aq[ks], bk, cqk); }
            const int j = 16 * jt + r; const float gj = gcs[j];
#pragma unroll
            for (int e = 0; e < 4; ++e) {
                const int i = 16 * it + 4 * q + e; const float gi = gcs[i];
                const float dec = (j <= i) ? __expf(gi - gj) : 0.f;
                Lm[j * 64 + i] = (j < i) ? bet[i] * ckk[e] * dec : 0.f;
                QKg[i * 64 + j] = f2bf(cqk[e] * dec);
            }
        }
    }
    __syncthreads();
    if (tid < 128) {
        const int c = tid;
        bf16* dst = (c < 64) ? (bf16*)(ws + WS_GU) + (size_t)(bh * SEQ + t0) * 64 + c : (bf16*)(ws + WS_GW) + (size_t)(bh * SEQ + t0) * 64 + (c - 64);
        LAS float* X = (LAS float*)(lds + 45056);
        for (int bi = 0; bi < 4; ++bi) {
            float acc[16];
#pragma unroll
            for (int i = 0; i < 16; ++i) { const int row = 16 * bi + i; const float be = bet[row];
                acc[i] = (c < 64) ? bf2f(Vb[row * 72 + c]) * be : bf2f(Kb[row * 72 + (c - 64)]) * be * __expf(gcs[row]); }
            for (int j = 0; j < 16 * bi; ++j) {
                const float xj = X[j * 128 + c];
                const LAS f32x4* lp = (const LAS f32x4*)(Lm + j * 64 + 16 * bi);
#pragma unroll
                for (int k = 0; k < 4; ++k) { const f32x4 lv = lp[k];
                    acc[4 * k + 0] -= lv[0] * xj; acc[4 * k + 1] -= lv[1] * xj; acc[4 * k + 2] -= lv[2] * xj; acc[4 * k + 3] -= lv[3] * xj; }
            }
#pragma unroll
            for (int j = 0; j < 16; ++j) {
                const float xj = acc[j];
                const LAS f32x4* lp = (const LAS f32x4*)(Lm + (16 * bi + j) * 64 + 16 * bi);
#pragma unroll
                for (int k = 0; k < 4; ++k) if (4 * k + 3 > j) { const f32x4 lv = lp[k];
#pragma unroll
                    for (int e = 0; e < 4; ++e) if (4 * k + e > j) acc[4 * k + e] -= lv[e] * xj; }
                asm volatile("" ::: "memory");
            }
#pragma unroll
            for (int i = 0; i < 16; ++i) { X[(16 * bi + i) * 128 + c] = acc[i]; dst[(16 * bi + i) * 64] = f2bf(acc[i]); }
        }
    } else {
        const float glast = gcs[63];
        bf16* QD = (bf16*)(ws + WS_GQD) + (size_t)(bh * SEQ + t0) * 64;
        bf16* KDT = (bf16*)(ws + WS_GKDT) + (size_t)(bh * 32 + n) * 4096;
        for (int task = tid - 128; task < 512; task += 384) {
            {
                const int tok = task >> 3, seg = task & 7; const float eg = __expf(gcs[tok]);
                const u32x4 xq = *(const LAS u32x4*)(Qb + tok * 72 + seg * 8);
                u32x4 o; o.x = pk2(bfw(xq.x, 0) * eg, bfw(xq.x, 1) * eg); o.y = pk2(bfw(xq.y, 0) * eg, bfw(xq.y, 1) * eg);
                o.z = pk2(bfw(xq.z, 0) * eg, bfw(xq.z, 1) * eg); o.w = pk2(bfw(xq.w, 0) * eg, bfw(xq.w, 1) * eg);
                *(u32x4*)(QD + tok * 64 + seg * 8) = o;
            }
            {
                const int d = task >> 3, is = task & 7; float kv[8];
#pragma unroll
                for (int e = 0; e < 8; ++e) { const int i = is * 8 + e; kv[e] = bf2f(Kb[i * 72 + d]) * __expf(glast - gcs[i]); }
                u32x4 o; o.x = pk2(kv[0], kv[1]); o.y = pk2(kv[2], kv[3]); o.z = pk2(kv[4], kv[5]); o.w = pk2(kv[6], kv[7]);
                *(u32x4*)(KDT + d * 64 + is * 8) = o;
            }
        }
        if (tid == 128) ((float*)(ws + WS_EGL))[bh * 32 + n] = __expf(glast);
    }
    __syncthreads();
}

__device__ __forceinline__ void hgrn_prep_item(const Args& a, int l, int item, LAS unsigned char* lds, int tid) {
    const int b = item >> 6, ch = item & 63, t0 = ch * 32;
    const int lane = tid & 63, wave = tid >> 6, r = lane & 15, q = lane >> 4;
    unsigned char* ws = a.ws;
    const bf16* H = (const bf16*)(ws + WS_H);
    LAS bf16* Qt = (LAS bf16*)lds;
    LAS bf16* Kt = Qt + 32 * 264;
    if (tid < 256) {
        const int c = tid;
        float lb = 0.f;
        if (l == 1) lb = 1.f / (1.f + __expf(a.in[10][c] - a.in[10][256 + c]));
        const float oml = 1.f - lb;
        float cum = 0.f; float kt[32]; unsigned vt[16];
        bf16* QT = (bf16*)(ws + WS_CQT) + (size_t)(b * SEQ + t0) * 256 + c;
#pragma unroll
        for (int t = 0; t < 32; ++t) {
            const bf16* row = H + (size_t)(b * SEQ + t0 + t) * DINP;
            const float fl = bf2f(row[HC_F + c]), qv = bf2f(row[HC_Q + c]); const unsigned iv = row[HC_I + c];
            const float sg = 1.f / (1.f + __expf(-fl));
            const float f = lb + oml * sg;
            cum += __logf(f);
            const float kk = oml / (1.f + __expf(fl));
            const float qt = qv * __expf(cum), ktl = kk * __expf(-cum);
            const bf16 qb = f2bf(qt);
            Qt[t * 264 + c] = qb; Kt[t * 264 + c] = f2bf(ktl); kt[t] = ktl;
            QT[(size_t)t * 256] = qb;
            if (t & 1) vt[t >> 1] |= iv << 16; else vt[t >> 1] = iv;
        }
        const float ecl = __expf(cum);
        ((float*)(ws + WS_ECL))[(size_t)(b * 64 + ch) * 256 + c] = ecl;
        bf16* KD = (bf16*)(ws + WS_CKDT) + ((size_t)(b * 64 + ch) * 256 + c) * 32;
        bf16* VT = (bf16*)(ws + WS_CVT) + ((size_t)(b * 64 + ch) * 256 + c) * 32;
#pragma unroll
        for (int g4 = 0; g4 < 4; ++g4) {
            u32x4 o; o.x = pk2(kt[8 * g4 + 0] * ecl, kt[8 * g4 + 1] * ecl); o.y = pk2(kt[8 * g4 + 2] * ecl, kt[8 * g4 + 3] * ecl);
            o.z = pk2(kt[8 * g4 + 4] * ecl, kt[8 * g4 + 5] * ecl); o.w = pk2(kt[8 * g4 + 6] * ecl, kt[8 * g4 + 7] * ecl);
            *(u32x4*)(KD + 8 * g4) = o;
            u32x4 v; v.x = vt[4 * g4 + 0]; v.y = vt[4 * g4 + 1]; v.z = vt[4 * g4 + 2]; v.w = vt[4 * g4 + 3];
            *(u32x4*)(VT + 8 * g4) = v;
        }
    }
    __syncthreads();
    {
        const int hh = wave >> 1, tt = wave & 1;
        bf16* AS = (bf16*)(ws + WS_CAS) + ((size_t)((b * 4 + hh) * 64 + ch) * 32) * 32;
        bf16x8 aq[2];
#pragma unroll
        for (int ks = 0; ks < 2; ++ks) aq[ks] = lds8(Qt + (16 * tt + r) * 264 + hh * 64 + 32 * ks + 8 * q);
#pragma unroll
        for (int st = 0; st < 2; ++st) {
            f32x4 acc = {0.f, 0.f, 0.f, 0.f};
#pragma unroll
            for (int ks = 0; ks < 2; ++ks) acc = MFMA16(aq[ks], lds8(Kt + (16 * st + r) * 264 + hh * 64 + 32 * ks + 8 * q), acc);
            const int s = 16 * st + r;
#pragma unroll
            for (int e = 0; e < 4; ++e) { const int t = 16 * tt + 4 * q + e; AS[t * 32 + s] = f2bf(s <= t ? acc[e] : 0.f); }
        }
    }
    __syncthreads();
}

__device__ __forceinline__ void mla_prep_item(const Args& a, int l, int item, LAS unsigned char* lds, int tid) {
    const int g0 = item * 32;
    const int lane = tid & 63, wave = tid >> 6, r = lane & 15, q = lane >> 4;
    unsigned char* ws = a.ws;
    const bf16* H = (const bf16*)(ws + WS_H);
    LAS bf16* Cq = (LAS bf16*)lds;
    LAS bf16* Ckv = Cq + 32 * 200;
    const float LOG2_10000 = 13.287712379549449f;
    {
        const int tok = tid >> 4, sub = tid & 15; const bf16* row = H + (size_t)(g0 + tok) * DINP;
        float xv[12]; float ss = 0.f;
#pragma unroll
        for (int k = 0; k < 3; ++k) { const u32x2 w = *(const u32x2*)(row + HB_CQ + sub * 12 + 4 * k);
            xv[4 * k + 0] = bfw(w.x, 0); xv[4 * k + 1] = bfw(w.x, 1); xv[4 * k + 2] = bfw(w.y, 0); xv[4 * k + 3] = bfw(w.y, 1); }
#pragma unroll
        for (int e = 0; e < 12; ++e) ss += xv[e] * xv[e];
        ss += __shfl_xor(ss, 1); ss += __shfl_xor(ss, 2); ss += __shfl_xor(ss, 4); ss += __shfl_xor(ss, 8);
        const float rq = rsqrtf(ss * (1.f / 192.f) + EPS);
        const float* gq = a.in[6] + l * 192 + sub * 12;
#pragma unroll
        for (int e = 0; e < 12; ++e) Cq[tok * 200 + sub * 12 + e] = f2bf(xv[e] * rq * gq[e]);
        const u32x4 w = *(const u32x4*)(row + HB_CKV + sub * 8);
        float yv[8]; float s2 = 0.f;
#pragma unroll
        for (int e = 0; e < 8; ++e) { yv[e] = bfw(w[e >> 1], e & 1); s2 += yv[e] * yv[e]; }
        s2 += __shfl_xor(s2, 1); s2 += __shfl_xor(s2, 2); s2 += __shfl_xor(s2, 4); s2 += __shfl_xor(s2, 8);
        const float rk = rsqrtf(s2 * (1.f / 128.f) + EPS);
        const float* gk = a.in[7] + l * 128 + sub * 8;
#pragma unroll
        for (int e = 0; e < 8; ++e) Ckv[tok * 136 + sub * 8 + e] = f2bf(yv[e] * rk * gk[e]);
        const int i = sub; const float pos = (float)((g0 + tok) & (SEQ - 1));
        const float ang = pos * exp2f(-(float)i * (LOG2_10000 / 16.f));
        float sn, cs; __sincosf(ang, &sn, &cs);
        const float x1 = bf2f(row[HB_KR + i]), x2 = bf2f(row[HB_KR + 16 + i]);
        bf16* KR = (bf16*)(ws + WS_MKR) + (size_t)(g0 + tok) * 32;
        KR[i] = f2bf(x1 * cs - x2 * sn); KR[16 + i] = f2bf(x1 * sn + x2 * cs);
    }
    __syncthreads();
    {
        const bf16* WUQ = (const bf16*)(ws + WS_WUQ);
        f32x4 acc[3][2];
#pragma unroll
        for (int k = 0; k < 3; ++k) { acc[k][0] = (f32x4){0.f, 0.f, 0.f, 0.f}; acc[k][1] = (f32x4){0.f, 0.f, 0.f, 0.f}; }
#pragma unroll
        for (int ks = 0; ks < 6; ++ks) {
            const bf16x8 a0 = lds8(Cq + r * 200 + 32 * ks + 8 * q), a1 = lds8(Cq + (16 + r) * 200 + 32 * ks + 8 * q);
#pragma unroll
            for (int k = 0; k < 3; ++k) { const bf16x8 bw = ldg8(WUQ + (size_t)(16 * (3 * wave + k) + r) * 192 + 32 * ks + 8 * q);
                acc[k][0] = MFMA16(a0, bw, acc[k][0]); acc[k][1] = MFMA16(a1, bw, acc[k][1]); }
        }
        bf16* MQ = (bf16*)(ws + WS_MQ);
        const float invf = exp2f(-(float)r * (LOG2_10000 / 16.f));
#pragma unroll
        for (int k = 0; k < 3; ++k) {
            const int nt = 3 * wave + k, head = nt / 6, sub = nt - head * 6;
#pragma unroll
            for (int mt = 0; mt < 2; ++mt)
#pragma unroll
                for (int e = 0; e < 4; ++e) {
                    const int g = g0 + 16 * mt + 4 * q + e; bf16* dst = MQ + ((size_t)g * 4 + head) * 96;
                    if (sub < 4) dst[sub * 16 + r] = f2bf(acc[k][mt][e]);
                    else if (sub == 4 && k < 2) {
                        const float pos = (float)(g & (SEQ - 1)); float sn, cs; __sincosf(pos * invf, &sn, &cs);
                        const float x1 = acc[k][mt][e], x2 = acc[(k + 1) % 3][mt][e];
                        dst[64 + r] = f2bf(x1 * cs - x2 * sn); dst[80 + r] = f2bf(x1 * sn + x2 * cs);
                    }
                }
        }
    }
    {
        const bf16* WUKV = (const bf16*)(ws + WS_WUKV);
        f32x4 acc[4][2];
#pragma unroll
        for (int k = 0; k < 4; ++k) { acc[k][0] = (f32x4){0.f, 0.f, 0.f, 0.f}; acc[k][1] = (f32x4){0.f, 0.f, 0.f, 0.f}; }
#pragma unroll
        for (int ks = 0; ks < 4; ++ks) {
            const bf16x8 a0 = lds8(Ckv + r * 136 + 32 * ks + 8 * q), a1 = lds8(Ckv + (16 + r) * 136 + 32 * ks + 8 * q);
#pragma unroll
            for (int k = 0; k < 4; ++k) { const bf16x8 bw = ldg8(WUKV + (size_t)(16 * (4 * wave + k) + r) * 128 + 32 * ks + 8 * q);
                acc[k][0] = MFMA16(a0, bw, acc[k][0]); acc[k][1] = MFMA16(a1, bw, acc[k][1]); }
        }
        const int head = wave >> 1;
        bf16* KN = (bf16*)(ws + WS_MKN); bf16* VT = (bf16*)(ws + WS_MVT);
#pragma unroll
        for (int k = 0; k < 4; ++k)
#pragma unroll
            for (int mt = 0; mt < 2; ++mt)
#pragma unroll
                for (int e = 0; e < 4; ++e) {
                    const int g = g0 + 16 * mt + 4 * q + e;
                    if ((wave & 1) == 0) KN[((size_t)g * 4 + head) * 64 + k * 16 + r] = f2bf(acc[k][mt][e]);
                    else { const int bb = g >> 11, t = g & (SEQ - 1); VT[((size_t)(bb * 4 + head) * 64 + k * 16 + r) * SEQ + (t & 3) * 512 + (t >> 2)] = f2bf(acc[k][mt][e]); }
                }
    }
    __syncthreads();
}

__device__ __forceinline__ void dsa_prep_item(const Args& a, int item, LAS unsigned char* lds, int tid) {
    const int g0 = item * 64, b = g0 >> 11, t0 = g0 & (SEQ - 1);
    unsigned char* ws = a.ws;
    const bf16* H = (const bf16*)(ws + WS_H);
    LAS bf16* Vt = (LAS bf16*)lds;
#pragma unroll
    for (int k = 0; k < 4; ++k) { const int idx = tid + 512 * k, row = idx >> 5, chn = idx & 31;
        *(LAS u32x4*)(Vt + row * 264 + chn * 8) = *(const u32x4*)(H + (size_t)(g0 + row) * DINP + HD_V + chn * 8); }
    __syncthreads();
    const int c = tid & 255, rp = tid >> 8;
    bf16* VT = (bf16*)(ws + WS_DVT) + ((size_t)(b * 4 + (c >> 6)) * 64 + (c & 63)) * SEQ;
#pragma unroll
    for (int k = 0; k < 2; ++k) {
        const int rr = 2 * rp + k; unsigned w[8];
#pragma unroll
        for (int m = 0; m < 8; ++m) w[m] = (unsigned)Vt[(rr + 8 * m) * 264 + c] | ((unsigned)Vt[(rr + 8 * m + 4) * 264 + c] << 16);
        u32x4 o0 = {w[0], w[1], w[2], w[3]}, o1 = {w[4], w[5], w[6], w[7]};
        bf16* dst = VT + rr * 512 + (t0 >> 2);
        *(u32x4*)dst = o0; *(u32x4*)(dst + 8) = o1;
    }
    __syncthreads();
}

__device__ __forceinline__ void norm_gate_store(const f32x4 (&o)[4], const bf16* gate_row  , const float* ng  , bf16* dst  , int q) {
    float ssq = 0.f;
#pragma unroll
    for (int et = 0; et < 4; ++et) ssq += (o[et][0] * o[et][0] + o[et][1] * o[et][1]) + (o[et][2] * o[et][2] + o[et][3] * o[et][3]);
    ssq += __shfl_xor(ssq, 16); ssq += __shfl_xor(ssq, 32);
    const float rinv = rsqrtf(ssq * (1.f / 64.f) + EPS);
#pragma unroll
    for (int et = 0; et < 4; ++et) {
        const int e0 = 16 * et + 4 * q;
        const u32x2 z = *(const u32x2*)(gate_row + e0);
        const f32x4 g4 = *(const f32x4*)(ng + e0);
        const float v0 = o[et][0] * rinv * g4[0] * siluf_(bfw(z.x, 0)), v1 = o[et][1] * rinv * g4[1] * siluf_(bfw(z.x, 1));
        const float v2 = o[et][2] * rinv * g4[2] * siluf_(bfw(z.y, 0)), v3 = o[et][3] * rinv * g4[3] * siluf_(bfw(z.y, 1));
        u32x2 w; w.x = pk2(v0, v1); w.y = pk2(v2, v3);
        *(u32x2*)(dst + e0) = w;
    }
}

__device__ __forceinline__ void gdn_scan(const Args& a, int l, int bh, LAS unsigned char* lds, int lane) {
    const int b = bh >> 2, hh = bh & 3, r = lane & 15, q = lane >> 4;
    unsigned char* ws = a.ws;
    const bf16* H = (const bf16*)(ws + WS_H);
    bf16* CC = (bf16*)(ws + WS_XB);
    LAS bf16* SsT = (LAS bf16*)lds;
    LAS bf16* VnT = SsT + 64 * 72;
    f32x4 st[4][4];
#pragma unroll
    for (int et = 0; et < 4; ++et)
#pragma unroll
        for (int dt = 0; dt < 4; ++dt) st[et][dt] = (f32x4){0.f, 0.f, 0.f, 0.f};
    for (int i = lane; i < 64 * 72 / 2; i += 64) ((LAS unsigned*)SsT)[i] = 0u;
    WAVE_SYNC();
    const float* ng = a.in[5] + l * 64;
    for (int n = 0; n < 32; ++n) {
        const bf16* Ub = (const bf16*)(ws + WS_GU) + (size_t)(bh * SEQ + n * 64) * 64;
        const bf16* Wb = (const bf16*)(ws + WS_GW) + (size_t)(bh * SEQ + n * 64) * 64;
        const bf16* QDb = (const bf16*)(ws + WS_GQD) + (size_t)(bh * SEQ + n * 64) * 64;
        const bf16* KDTb = (const bf16*)(ws + WS_GKDT) + (size_t)(bh * 32 + n) * 4096;
        const bf16* QKb = (const bf16*)(ws + WS_GQK) + (size_t)(bh * 32 + n) * 4096;
        const float eg = ((const float*)(ws + WS_EGL))[bh * 32 + n];
#pragma unroll
        for (int tt = 0; tt < 4; ++tt) {
            const bf16x8 bw0 = ldg8(Wb + (16 * tt + r) * 64 + 8 * q), bw1 = ldg8(Wb + (16 * tt + r) * 64 + 32 + 8 * q);
#pragma unroll
            for (int et = 0; et < 4; ++et) {
                f32x4 acc = {0.f, 0.f, 0.f, 0.f};
                acc = MFMA16(lds8(SsT + (16 * et + r) * 72 + 8 * q), bw0, acc);
                acc = MFMA16(lds8(SsT + (16 * et + r) * 72 + 32 + 8 * q), bw1, acc);
                const u32x2 u4 = *(const u32x2*)(Ub + (16 * tt + r) * 64 + 16 * et + 4 * q);
                const int e0 = 16 * et + 4 * q, t = 16 * tt + r;
                VnT[(e0 + 0) * 72 + t] = f2bf(bfw(u4.x, 0) - acc[0]); VnT[(e0 + 1) * 72 + t] = f2bf(bfw(u4.x, 1) - acc[1]);
                VnT[(e0 + 2) * 72 + t] = f2bf(bfw(u4.y, 0) - acc[2]); VnT[(e0 + 3) * 72 + t] = f2bf(bfw(u4.y, 1) - acc[3]);
            }
        }
        WAVE_SYNC();
#pragma unroll
        for (int it = 0; it < 4; ++it) {
            const bf16x8 bq0 = ldg8(QDb + (16 * it + r) * 64 + 8 * q), bq1 = ldg8(QDb + (16 * it + r) * 64 + 32 + 8 * q);
            const bf16x8 bk0 = ldg8(QKb + (16 * it + r) * 64 + 8 * q), bk1 = ldg8(QKb + (16 * it + r) * 64 + 32 + 8 * q);
            f32x4 o[4];
#pragma unroll
            for (int et = 0; et < 4; ++et) {
                f32x4 acc = {0.f, 0.f, 0.f, 0.f};
                acc = MFMA16(lds8(SsT + (16 * et + r) * 72 + 8 * q), bq0, acc);
                acc = MFMA16(lds8(SsT + (16 * et + r) * 72 + 32 + 8 * q), bq1, acc);
                acc = MFMA16(lds8(VnT + (16 * et + r) * 72 + 8 * q), bk0, acc);
                acc = MFMA16(lds8(VnT + (16 * et + r) * 72 + 32 + 8 * q), bk1, acc);
                o[et] = acc;
            }
            const size_t g = (size_t)b * SEQ + n * 64 + 16 * it + r;
            norm_gate_store(o, H + g * DINP + HA_Z + hh * 64, ng, CC + g * DM + 0 + hh * 64, q);
        }
#pragma unroll
        for (int dt = 0; dt < 4; ++dt) {
            const bf16x8 bk0 = ldg8(KDTb + (16 * dt + r) * 64 + 8 * q), bk1 = ldg8(KDTb + (16 * dt + r) * 64 + 32 + 8 * q);
#pragma unroll
            for (int et = 0; et < 4; ++et) {
                f32x4 acc = st[et][dt] * eg;
                acc = MFMA16(lds8(VnT + (16 * et + r) * 72 + 8 * q), bk0, acc);
                acc = MFMA16(lds8(VnT + (16 * et + r) * 72 + 32 + 8 * q), bk1, acc);
                st[et][dt] = acc;
            }
        }
        WAVE_SYNC();
#pragma unroll
        for (int et = 0; et < 4; ++et)
#pragma unroll
            for (int dt = 0; dt < 4; ++dt)
#pragma unroll
                for (int e = 0; e < 4; ++e) SsT[(16 * et + 4 * q + e) * 72 + 16 * dt + r] = f2bf(st[et][dt][e]);
        WAVE_SYNC();
    }
}

__device__ __forceinline__ void hgrn_scan(const Args& a, int l, int bh, LAS unsigned char* lds, int lane) {
    const int b = bh >> 2, hh = bh & 3, r = lane & 15, q = lane >> 4;
    unsigned char* ws = a.ws;
    const bf16* H = (const bf16*)(ws + WS_H);
    bf16* CC = (bf16*)(ws + WS_XB);
    LAS bf16* SsT = (LAS bf16*)lds;
    f32x4 st[4][4];
#pragma unroll
    for (int et = 0; et < 4; ++et)
#pragma unroll
        for (int dt = 0; dt < 4; ++dt) st[et][dt] = (f32x4){0.f, 0.f, 0.f, 0.f};
    for (int i = lane; i < 64 * 72 / 2; i += 64) ((LAS unsigned*)SsT)[i] = 0u;
    WAVE_SYNC();
    const float* ng = a.in[11] + l * 64;
    for (int ch = 0; ch < 64; ++ch) {
        const size_t g0 = (size_t)b * SEQ + ch * 32;
        const bf16* VTb = (const bf16*)(ws + WS_CVT) + ((size_t)(b * 64 + ch) * 256 + hh * 64) * 32;
        const bf16* KDb = (const bf16*)(ws + WS_CKDT) + ((size_t)(b * 64 + ch) * 256 + hh * 64) * 32;
        const bf16* QTb = (const bf16*)(ws + WS_CQT) + g0 * 256 + hh * 64;
        const bf16* ASb = (const bf16*)(ws + WS_CAS) + ((size_t)(bh * 64 + ch) * 32) * 32;
        const float* ECb = (const float*)(ws + WS_ECL) + (size_t)(b * 64 + ch) * 256 + hh * 64;
        bf16x8 va[4];
#pragma unroll
        for (int et = 0; et < 4; ++et) va[et] = ldg8(VTb + (16 * et + r) * 32 + 8 * q);
#pragma unroll
        for (int tt = 0; tt < 2; ++tt) {
            const bf16x8 bq0 = ldg8(QTb + (size_t)(16 * tt + r) * 256 + 8 * q), bq1 = ldg8(QTb + (size_t)(16 * tt + r) * 256 + 32 + 8 * q);
            const bf16x8 ba = ldg8(ASb + (16 * tt + r) * 32 + 8 * q);
            f32x4 o[4];
#pragma unroll
            for (int et = 0; et < 4; ++et) {
                f32x4 acc = {0.f, 0.f, 0.f, 0.f};
                acc = MFMA16(lds8(SsT + (16 * et + r) * 72 + 8 * q), bq0, acc);
                acc = MFMA16(lds8(SsT + (16 * et + r) * 72 + 32 + 8 * q), bq1, acc);
                acc = MFMA16(va[et], ba, acc);
                o[et] = acc;
            }
            const size_t g = g0 + 16 * tt + r;
            norm_gate_store(o, H + g * DINP + HC_G + hh * 64, ng, CC + g * DM + 512 + hh * 64, q);
        }
#pragma unroll
        for (int dt = 0; dt < 4; ++dt) {
            const float ec = ECb[16 * dt + r];
            const bf16x8 bk = ldg8(KDb + (16 * dt + r) * 32 + 8 * q);
#pragma unroll
            for (int et = 0; et < 4; ++et) st[et][dt] = MFMA16(va[et], bk, st[et][dt] * ec);
        }
        WAVE_SYNC();
#pragma unroll
        for (int et = 0; et < 4; ++et)
#pragma unroll
            for (int dt = 0; dt < 4; ++dt)
#pragma unroll
                for (int e = 0; e < 4; ++e) SsT[(16 * et + 4 * q + e) * 72 + 16 * dt + r] = f2bf(st[et][dt][e]);
        WAVE_SYNC();
    }
}

template <int DSA>
__device__ __forceinline__ void attn_item(const Args& a, int idx, int lane) {
    const int n = 15 - (idx >> 7), rem = idx & 127, b = rem >> 4, hh = (rem >> 2) & 3, rq = rem & 3;
    const int r = lane & 15, q = lane >> 4;
    unsigned char* ws = a.ws;
    const bf16* H = (const bf16*)(ws + WS_H);
    constexpr int NDS = DSA ? 2 : 3;
    const int tq0 = 128 * n + rq + 4 * r;
    const bf16* VT = (const bf16*)(ws + (DSA ? WS_DVT : WS_MVT)) + (size_t)(b * 4 + hh) * 64 * SEQ;
    bf16x8 qf[2][NDS];
#pragma unroll
    for (int qi = 0; qi < 2; ++qi) {
        const size_t g = (size_t)b * SEQ + tq0 + 64 * qi;
#pragma unroll
        for (int ds = 0; ds < NDS; ++ds)
            qf[qi][ds] = DSA ? ldg8(H + g * DINP + HD_Q + hh * 64 + 32 * ds + 8 * q) : ldg8((const bf16*)(ws + WS_MQ) + (g * 4 + hh) * 96 + 32 * ds + 8 * q);
    }
    f32x4 o[2][4];
#pragma unroll
    for (int qi = 0; qi < 2; ++qi)
#pragma unroll
        for (int et = 0; et < 4; ++et) o[qi][et] = (f32x4){0.f, 0.f, 0.f, 0.f};
    float mrun[2] = {-1e30f, -1e30f}, lrun[2] = {0.f, 0.f};
    const float sc = (DSA ? 0.125f : 0.10206207261596575f) * LOG2E;
    const float slope2 = exp2f(-2.f * (float)(hh + 1)) * LOG2E;
    const int nd = (n == 0) ? 4 : 8;
    const int ng = DSA ? (nd + (n >= 2 ? n - 1 : 0)) : 4 * (n + 1);
    for (int gi = 0; gi < ng; ++gi) {
        int p, rp;
        if (DSA) { if (gi < nd) { p = (n == 0 ? 0 : n - 1 + (gi >> 2)); rp = gi & 3; } else { p = gi - nd; rp = rq; } }
        else { p = gi >> 2; rp = gi & 3; }
        const int sa = 128 * p + rp + 4 * (8 * (r >> 2) + (r & 3));
        bf16x8 kf[2][NDS];
#pragma unroll
        for (int kt = 0; kt < 2; ++kt) {
            const size_t g = (size_t)b * SEQ + sa + 16 * kt;
#pragma unroll
            for (int ds = 0; ds < NDS; ++ds) {
                if (DSA) kf[kt][ds] = ldg8(H + g * DINP + HD_K + hh * 64 + 32 * ds + 8 * q);
                else kf[kt][ds] = (ds < 2) ? ldg8((const bf16*)(ws + WS_MKN) + (g * 4 + hh) * 64 + 32 * ds + 8 * q) : ldg8((const bf16*)(ws + WS_MKR) + g * 32 + 8 * q);
            }
        }
        bf16x8 vf[4];
#pragma unroll
        for (int et = 0; et < 4; ++et) vf[et] = ldg8(VT + (size_t)(16 * et + r) * SEQ + rp * 512 + 32 * p + 8 * q);
        const int sbase = 128 * p + rp + 4 * (8 * q);
#pragma unroll
        for (int qi = 0; qi < 2; ++qi) {
            f32x4 s[2];
#pragma unroll
            for (int kt = 0; kt < 2; ++kt) { f32x4 acc = {0.f, 0.f, 0.f, 0.f};
#pragma unroll
                for (int ds = 0; ds < NDS; ++ds) acc = MFMA16(kf[kt][ds], qf[qi][ds], acc);
                s[kt] = acc; }
            const int tq = tq0 + 64 * qi;
            float sv[8]; bool ok[8]; float mx = -1e30f;
#pragma unroll
            for (int j = 0; j < 8; ++j) {
                const int d = tq - (sbase + 4 * j);
                float val = s[j >> 2][j & 3] * sc;
                if (DSA) {
                    const int mult = (d <= 128 ? 1 : 0) + (((d & 3) == 0 && d <= 512) ? 1 : 0) + (((d & 15) == 0) ? 1 : 0);
                    ok[j] = (d >= 0) && (mult > 0);
                    val += -slope2 * (float)d + (mult == 3 ? 1.5849625007211562f : (mult == 2 ? 1.f : 0.f));
                } else ok[j] = (d >= 0);
                sv[j] = ok[j] ? val : -1e30f;
                mx = fmaxf(mx, sv[j]);
            }
            mx = fmaxf(mx, __shfl_xor(mx, 16)); mx = fmaxf(mx, __shfl_xor(mx, 32));
            const float mn = fmaxf(mrun[qi], mx), alpha = exp2f(mrun[qi] - mn);
            mrun[qi] = mn;
            float pv[8]; float rs = 0.f;
#pragma unroll
            for (int j = 0; j < 8; ++j) { pv[j] = ok[j] ? exp2f(sv[j] - mn) : 0.f; rs += pv[j]; }
            lrun[qi] = lrun[qi] * alpha + rs;
            union { bf16x8 v; unsigned w[4]; } pf;
            pf.w[0] = pk2(pv[0], pv[1]); pf.w[1] = pk2(pv[2], pv[3]); pf.w[2] = pk2(pv[4], pv[5]); pf.w[3] = pk2(pv[6], pv[7]);
#pragma unroll
            for (int et = 0; et < 4; ++et) { f32x4 acc = o[qi][et] * alpha; o[qi][et] = MFMA16(vf[et], pf.v, acc); }
        }
    }
    bf16* CC = (bf16*)(ws + WS_XB);
#pragma unroll
    for (int qi = 0; qi < 2; ++qi) {
        float lt = lrun[qi]; lt += __shfl_xor(lt, 16); lt += __shfl_xor(lt, 32);
        const float inv = 1.f / lt;
        bf16* dst = CC + ((size_t)b * SEQ + tq0 + 64 * qi) * DM + (DSA ? 768 : 256) + hh * 64;
#pragma unroll
        for (int et = 0; et < 4; ++et) { u32x2 w; w.x = pk2(o[qi][et][0] * inv, o[qi][et][1] * inv); w.y = pk2(o[qi][et][2] * inv, o[qi][et][3] * inv);
            *(u32x2*)(dst + 16 * et + 4 * q) = w; }
    }
}

#define BAR_SYNC() do { asm volatile("s_waitcnt lgkmcnt(0)" ::: "memory"); __builtin_amdgcn_s_barrier(); asm volatile("" ::: "memory"); } while (0)

__device__ __forceinline__ void gdn_scan_blk(const Args& a, int l, int bh, LAS unsigned char* lds, int tid) {
    const int lane = tid & 63, wave = __builtin_amdgcn_readfirstlane(tid >> 6), r = lane & 15, q = lane >> 4, eq = wave & 3, th = wave >> 2;
    const int b = bh >> 2, hh = bh & 3;
    unsigned char* ws = a.ws;
    const bf16* H = (const bf16*)(ws + WS_H);
    bf16* CC = (bf16*)(ws + WS_XB);
    constexpr int MAT = 64 * 72;
    LAS bf16* OPB = (LAS bf16*)lds;
    LAS bf16* SsT = OPB + 2 * 5 * MAT;
    LAS bf16* VnT = SsT + MAT;
    LAS float* SSQ = (LAS float*)(VnT + MAT);
    const bf16* gU = (const bf16*)(ws + WS_GU) + (size_t)bh * SEQ * 64 + tid * 8;
    const bf16* gW = (const bf16*)(ws + WS_GW) + (size_t)bh * SEQ * 64 + tid * 8;
    const bf16* gQD = (const bf16*)(ws + WS_GQD) + (size_t)bh * SEQ * 64 + tid * 8;
    const bf16* gKDT = (const bf16*)(ws + WS_GKDT) + (size_t)bh * 32 * 4096 + tid * 8;
    const bf16* gQK = (const bf16*)(ws + WS_GQK) + (size_t)bh * 32 * 4096 + tid * 8;
    const float* gEG = (const float*)(ws + WS_EGL) + bh * 32;
    const int lo = (tid >> 3) * 72 + (tid & 7) * 8;
    u32x4 pf[5];
#define GDN_LOAD(n) do { pf[0] = *(const u32x4*)(gU + (size_t)(n) * 4096); pf[1] = *(const u32x4*)(gW + (size_t)(n) * 4096); pf[2] = *(const u32x4*)(gQD + (size_t)(n) * 4096); \
                         pf[3] = *(const u32x4*)(gKDT + (size_t)(n) * 4096); pf[4] = *(const u32x4*)(gQK + (size_t)(n) * 4096); } while (0)
#define GDN_STORE(bufi) do { LAS bf16* ob = OPB + (bufi) * 5 * MAT + lo; _Pragma("unroll") for (int m_ = 0; m_ < 5; ++m_) *(LAS u32x4*)(ob + m_ * MAT) = pf[m_]; } while (0)
    GDN_LOAD(0);
    for (int i = tid; i < MAT / 2; i += 512) ((LAS unsigned*)SsT)[i] = 0u;
    GDN_STORE(0);
    f32x4 st[2] = {(f32x4){0.f, 0.f, 0.f, 0.f}, (f32x4){0.f, 0.f, 0.f, 0.f}};
    const f32x4 ng4 = *(const f32x4*)(a.in[5] + l * 64 + 16 * eq + 4 * q);
    BAR_SYNC();
    for (int n = 0; n < 32; ++n) {
        const LAS bf16* bU = OPB + (n & 1) * 5 * MAT; const LAS bf16* bW = bU + MAT; const LAS bf16* bQD = bU + 2 * MAT; const LAS bf16* bKDT = bU + 3 * MAT; const LAS bf16* bQK = bU + 4 * MAT;
        if (n + 1 < 32) GDN_LOAD(n + 1);
        const float eg = gEG[n];
        const bf16x8 sa0 = lds8(SsT + (16 * eq + r) * 72 + 8 * q), sa1 = lds8(SsT + (16 * eq + r) * 72 + 32 + 8 * q);
#pragma unroll
        for (int k = 0; k < 2; ++k) {
            const int tt = 2 * th + k;
            f32x4 acc = {0.f, 0.f, 0.f, 0.f};
            acc = MFMA16(sa0, lds8(bW + (16 * tt + r) * 72 + 8 * q), acc);
            acc = MFMA16(sa1, lds8(bW + (16 * tt + r) * 72 + 32 + 8 * q), acc);
            const u32x2 u4 = *(const LAS u32x2*)(bU + (16 * tt + r) * 72 + 16 * eq + 4 * q);
            const int e0 = 16 * eq + 4 * q, t = 16 * tt + r;
            VnT[(e0 + 0) * 72 + t] = f2bf(bfw(u4.x, 0) - acc[0]); VnT[(e0 + 1) * 72 + t] = f2bf(bfw(u4.x, 1) - acc[1]);
            VnT[(e0 + 2) * 72 + t] = f2bf(bfw(u4.y, 0) - acc[2]); VnT[(e0 + 3) * 72 + t] = f2bf(bfw(u4.y, 1) - acc[3]);
        }
        BAR_SYNC();
        const bf16x8 va0 = lds8(VnT + (16 * eq + r) * 72 + 8 * q), va1 = lds8(VnT + (16 * eq + r) * 72 + 32 + 8 * q);
        f32x4 o[2]; u32x2 zg[2];
#pragma unroll
        for (int k = 0; k < 2; ++k) {
            const int it = 2 * th + k;
            f32x4 acc = {0.f, 0.f, 0.f, 0.f};
            acc = MFMA16(sa0, lds8(bQD + (16 * it + r) * 72 + 8 * q), acc);
            acc = MFMA16(sa1, lds8(bQD + (16 * it + r) * 72 + 32 + 8 * q), acc);
            acc = MFMA16(va0, lds8(bQK + (16 * it + r) * 72 + 8 * q), acc);
            acc = MFMA16(va1, lds8(bQK + (16 * it + r) * 72 + 32 + 8 * q), acc);
            o[k] = acc;
            float ss = (acc[0] * acc[0] + acc[1] * acc[1]) + (acc[2] * acc[2] + acc[3] * acc[3]);
            ss += __shfl_xor(ss, 16); ss += __shfl_xor(ss, 32);
            if (q == 0) SSQ[eq * 64 + 16 * it + r] = ss;
            const size_t g = (size_t)b * SEQ + n * 64 + 16 * it + r;
            zg[k] = *(const u32x2*)(H + g * DINP + HA_Z + hh * 64 + 16 * eq + 4 * q);
        }
        BAR_SYNC();
#pragma unroll
        for (int k = 0; k < 2; ++k) {
            const int i = 16 * (2 * th + k) + r;
            const float tot = (SSQ[i] + SSQ[64 + i]) + (SSQ[128 + i] + SSQ[192 + i]);
            const float rinv = rsqrtf(tot * (1.f / 64.f) + EPS);
            const float v0 = o[k][0] * rinv * ng4[0] * siluf_(bfw(zg[k].x, 0)), v1 = o[k][1] * rinv * ng4[1] * siluf_(bfw(zg[k].x, 1));
            const float v2 = o[k][2] * rinv * ng4[2] * siluf_(bfw(zg[k].y, 0)), v3 = o[k][3] * rinv * ng4[3] * siluf_(bfw(zg[k].y, 1));
            u32x2 w; w.x = pk2(v0, v1); w.y = pk2(v2, v3);
            *(u32x2*)(CC + ((size_t)b * SEQ + n * 64 + i) * DM + 0 + hh * 64 + 16 * eq + 4 * q) = w;
        }
#pragma unroll
        for (int k = 0; k < 2; ++k) {
            const int dt = 2 * th + k;
            f32x4 acc = st[k] * eg;
            acc = MFMA16(va0, lds8(bKDT + (16 * dt + r) * 72 + 8 * q), acc);
            acc = MFMA16(va1, lds8(bKDT + (16 * dt + r) * 72 + 32 + 8 * q), acc);
            st[k] = acc;
#pragma unroll
            for (int e = 0; e < 4; ++e) SsT[(16 * eq + 4 * q + e) * 72 + 16 * dt + r] = f2bf(acc[e]);
        }
        if (n + 1 < 32) GDN_STORE((n + 1) & 1);
        BAR_SYNC();
    }
#undef GDN_LOAD
#undef GDN_STORE
}

__device__ __forceinline__ void hgrn_scan_blk(const Args& a, int l, int bh, LAS unsigned char* lds, int tid) {
    const int lane = tid & 63, wave = __builtin_amdgcn_readfirstlane(tid >> 6), r = lane & 15, q = lane >> 4, eq = wave & 3, th = wave >> 2;
    const int b = bh >> 2, hh = bh & 3;
    unsigned char* ws = a.ws;
    const bf16* H = (const bf16*)(ws + WS_H);
    bf16* CC = (bf16*)(ws + WS_XB);
    constexpr int O_VT = 0, O_KD = 64 * 40, O_QT = 2 * 64 * 40, O_AS = O_QT + 32 * 72, BUF = O_AS + 32 * 40;
    LAS bf16* OPB = (LAS bf16*)lds;
    LAS float* ECB = (LAS float*)(OPB + 2 * BUF);
    LAS bf16* SsT = (LAS bf16*)(ECB + 128);
    LAS float* SSQ = (LAS float*)(SsT + 64 * 72);
    const int xa = tid & 255;
    const bf16* gA = (const bf16*)(ws + (tid < 256 ? WS_CVT : WS_CKDT)) + ((size_t)(b * 64) * 256 + hh * 64) * 32 + xa * 8;
    const int loA = (tid < 256 ? O_VT : O_KD) + (xa >> 2) * 40 + (xa & 3) * 8;
    const bf16* gQT = (const bf16*)(ws + WS_CQT) + ((size_t)b * SEQ + (xa >> 3)) * 256 + hh * 64 + (xa & 7) * 8;
    const int loQT = O_QT + (xa >> 3) * 72 + (xa & 7) * 8;
    const int xs = (tid - 256) & 127;
    const bf16* gAS = (const bf16*)(ws + WS_CAS) + ((size_t)(bh * 64) * 32) * 32 + xs * 8;
    const int loAS = O_AS + (xs >> 2) * 40 + (xs & 3) * 8;
    const float* gEC = (const float*)(ws + WS_ECL) + (size_t)(b * 64) * 256 + hh * 64 + (tid & 63);
    u32x4 pA, pB; float pE = 0.f;
#define HG_LOAD(ch) do { pA = *(const u32x4*)(gA + (size_t)(ch) * 8192); \
        if (tid < 256) pB = *(const u32x4*)(gQT + (size_t)(ch) * 8192); else if (tid < 384) pB = *(const u32x4*)(gAS + (size_t)(ch) * 1024); else if (tid < 448) pE = gEC[(size_t)(ch) * 256]; } while (0)
#define HG_STORE(bufi) do { LAS bf16* ob = OPB + (bufi) * BUF; *(LAS u32x4*)(ob + loA) = pA; \
        if (tid < 256) *(LAS u32x4*)(ob + loQT) = pB; else if (tid < 384) *(LAS u32x4*)(ob + loAS) = pB; else if (tid < 448) ECB[(bufi) * 64 + (tid & 63)] = pE; } while (0)
    HG_LOAD(0);
    for (int i = tid; i < 64 * 72 / 2; i += 512) ((LAS unsigned*)SsT)[i] = 0u;
    HG_STORE(0);
    f32x4 st[2] = {(f32x4){0.f, 0.f, 0.f, 0.f}, (f32x4){0.f, 0.f, 0.f, 0.f}};
    const f32x4 ng4 = *(const f32x4*)(a.in[11] + l * 64 + 16 * eq + 4 * q);
    BAR_SYNC();
    for (int ch = 0; ch < 64; ++ch) {
        const LAS bf16* ob = OPB + (ch & 1) * BUF;
        if (ch + 1 < 64) HG_LOAD(ch + 1);
        const bf16x8 sa0 = lds8(SsT + (16 * eq + r) * 72 + 8 * q), sa1 = lds8(SsT + (16 * eq + r) * 72 + 32 + 8 * q);
        const bf16x8 va = lds8(ob + O_VT + (16 * eq + r) * 40 + 8 * q);
        f32x4 acc = {0.f, 0.f, 0.f, 0.f};
        acc = MFMA16(sa0, lds8(ob + O_QT + (16 * th + r) * 72 + 8 * q), acc);
        acc = MFMA16(sa1, lds8(ob + O_QT + (16 * th + r) * 72 + 32 + 8 * q), acc);
        acc = MFMA16(va, lds8(ob + O_AS + (16 * th + r) * 40 + 8 * q), acc);
        float ss = (acc[0] * acc[0] + acc[1] * acc[1]) + (acc[2] * acc[2] + acc[3] * acc[3]);
        ss += __shfl_xor(ss, 16); ss += __shfl_xor(ss, 32);
        if (q == 0) SSQ[eq * 32 + 16 * th + r] = ss;
        const size_t g = (size_t)b * SEQ + ch * 32 + 16 * th + r;
        const u32x2 zg = *(const u32x2*)(H + g * DINP + HC_G + hh * 64 + 16 * eq + 4 * q);
        BAR_SYNC();
        {
            const int i = 16 * th + r;
            const float tot = (SSQ[i] + SSQ[32 + i]) + (SSQ[64 + i] + SSQ[96 + i]);
            const float rinv = rsqrtf(tot * (1.f / 64.f) + EPS);
            const float v0 = acc[0] * rinv * ng4[0] * siluf_(bfw(zg.x, 0)), v1 = acc[1] * rinv * ng4[1] * siluf_(bfw(zg.x, 1));
            const float v2 = acc[2] * rinv * ng4[2] * siluf_(bfw(zg.y, 0)), v3 = acc[3] * rinv * ng4[3] * siluf_(bfw(zg.y, 1));
            u32x2 w; w.x = pk2(v0, v1); w.y = pk2(v2, v3);
            *(u32x2*)(CC + g * DM + 512 + hh * 64 + 16 * eq + 4 * q) = w;
        }
#pragma unroll
        for (int k = 0; k < 2; ++k) {
            const int dt = 2 * th + k;
            const float ec = ECB[(ch & 1) * 64 + 16 * dt + r];
            const f32x4 nv = MFMA16(va, lds8(ob + O_KD + (16 * dt + r) * 40 + 8 * q), st[k] * ec);
            st[k] = nv;
#pragma unroll
            for (int e = 0; e < 4; ++e) SsT[(16 * eq + 4 * q + e) * 72 + 16 * dt + r] = f2bf(nv[e]);
        }
        if (ch + 1 < 64) HG_STORE((ch + 1) & 1);
        BAR_SYNC();
    }
#undef HG_LOAD
#undef HG_STORE
}
#ifdef NO_A
#define DIS_A(x)
#else
#define DIS_A(x) x
#endif
#ifdef NO_B
#define DIS_B(x)
#else
#define DIS_B(x) x
#endif
#ifdef NO_C
#define DIS_C(x)
#else
#define DIS_C(x) x
#endif
#ifdef NO_D
#define DIS_D(x)
#else
#define DIS_D(x) x
#endif
#ifdef NO_E
#define DIS_E(x)
#else
#define DIS_E(x) x
#endif
#ifdef NO_F
#define DIS_F(x)
#else
#define DIS_F(x) x
#endif
#ifdef NO_G
#define DIS_G(x)
#else
#define DIS_G(x) x
#endif
#ifdef NO_H
#define DIS_H(x)
#else
#define DIS_H(x) x
#endif

constexpr int NPHASE = 17;
constexpr int NWAVES = 8;
#ifndef MK_SPLIT
#define MK_SPLIT 0
#endif

template <int ph>
__device__ __forceinline__ void run_phase(const Args& args, LAS unsigned char* lds, int tid, int lane, int wave, int G, int bx, int gw, int NGW) {
    unsigned char* ws = args.ws;
    unsigned* ctl = (unsigned*)(ws + WS_CTL);
    if constexpr (ph == 0) {
            convert_weights(args, 0, 0, lds, gw, NGW, wave, lane);
            const float* x = args.in[0]; bf16* xb = (bf16*)(ws + WS_XB);
            for (size_t i = (size_t)gw * 64 + lane; i < (size_t)MTOK * DM / 8; i += (size_t)NGW * 64) {
                const f32x4 v0 = ((const f32x4*)x)[2 * i], v1 = ((const f32x4*)x)[2 * i + 1];
                u32x4 o; o.x = pk2(v0.x, v0.y); o.y = pk2(v0.z, v0.w); o.z = pk2(v1.x, v1.y); o.w = pk2(v1.z, v1.w);
                ((u32x4*)xb)[i] = o;
            }
            if (bx == 0 && tid < 64) ctl[tid] = 0u;
        } else {
            constexpr int l = (ph - 1) >> 3, sub = (ph - 1) & 7;
            if constexpr (sub == 0) {
                pg8::Gemm g{(const pg8::bf16_t*)(ws + WS_XB), (const pg8::bf16_t*)(ws + WS_WIN), MTOK, DINP, DM};
                pg8::StaticOrder S; S.init(MTOK, DINP, G, bx);
                pg8::EpiBf16<0> E{(pg8::bf16_t*)(ws + WS_H), DINP};
                pg8::gemm_phase<pg8::EpiBf16<0>, pg8::StaticOrder, true, true>(lds, g, S, E);
            } else if constexpr (sub == 1) {
                constexpr int N_GDN = 1024, N_MLA = 512, N_HG = 512, N_DSA = 256, NIT = N_GDN + N_MLA + N_HG + N_DSA;
                for (int it = bx; it < NIT; it += G) {
                    if (it < N_GDN) { DIS_A(gdn_prep_item(args, l, it, lds, tid)); }
                    else if (it < N_GDN + N_MLA) { DIS_B(mla_prep_item(args, l, it - N_GDN, lds, tid)); }
                    else if (it < N_GDN + N_MLA + N_HG) { DIS_C(hgrn_prep_item(args, l, it - N_GDN - N_MLA, lds, tid)); }
                    else { DIS_D(dsa_prep_item(args, it - N_GDN - N_MLA - N_HG, lds, tid)); }
                }
            } else if constexpr (sub == 2) {
                if (bx < 32) { DIS_E(gdn_scan_blk(args, l, bx, lds, tid)); }
                else if (bx < 64) { DIS_F(hgrn_scan_blk(args, l, bx - 32, lds, tid)); }
                for (;;) {
                    int idx = 0;
                    if (lane == 0) idx = (int)atomicAdd(ctl + l, 1u);
                    idx = __builtin_amdgcn_readfirstlane(idx);
                    if (idx >= 4096) break;
                    if (idx < 2048) { DIS_G(attn_item<0>(args, idx, lane)); } else { DIS_H(attn_item<1>(args, idx - 2048, lane)); }
                }
            } else if constexpr (sub == 3) {
                pg8::Gemm g{(const pg8::bf16_t*)(ws + WS_XB), (const pg8::bf16_t*)(ws + WS_WOUT), MTOK, DM, DM};
                pg8::StaticOrder S; S.init(MTOK, DM, G, bx);
                pg8::EpiRes E{l == 0 ? args.in[0] : args.out, args.out, DM, ALPHA};
                pg8::gemm_phase<pg8::EpiRes, pg8::StaticOrder, true, true>(lds, g, S, E);
            } else if constexpr (sub == 4 || sub == 7) {
                const float* gg = args.in[sub == 4 ? 13 : 17] + l * DM; const float* bb = args.in[sub == 4 ? 14 : 18] + l * DM;
                for (int m = gw; m < MTOK; m += NGW) ln_row(args.out + (size_t)m * DM, args.out + (size_t)m * DM, (bf16*)(ws + WS_XB) + (size_t)m * DM, gg, bb, lane);
                if (sub == 4) convert_weights(args, l, 1, lds, gw, NGW, wave, lane);
                else if (l == 0) convert_weights(args, 1, 0, lds, gw, NGW, wave, lane);
            } else if constexpr (sub == 5) {
                pg8::Gemm g{(const pg8::bf16_t*)(ws + WS_XB), (const pg8::bf16_t*)(ws + WS_W1), MTOK, DFF, DM};
                pg8::StaticOrder S; S.init(MTOK, DFF, G, bx);
                pg8::EpiBf16<2> E{(pg8::bf16_t*)(ws + WS_H), DFF};
                pg8::gemm_phase<pg8::EpiBf16<2>, pg8::StaticOrder, true, true>(lds, g, S, E);
            } else {
                pg8::Gemm g{(const pg8::bf16_t*)(ws + WS_H), (const pg8::bf16_t*)(ws + WS_W2), MTOK, DM, DFF};
                pg8::StaticOrder S; S.init(MTOK, DM, G, bx);
                pg8::EpiRes E{args.out, args.out, DM, ALPHA};
                pg8::gemm_phase<pg8::EpiRes, pg8::StaticOrder, true, true>(lds, g, S, E);
            }
        }
}

__global__ void __launch_bounds__(NWAVES * 64, 2) hybrid_fwd(Args args) {
    extern __shared__ __attribute__((aligned(16))) unsigned char lds_raw[];
    LAS unsigned char* lds = (LAS unsigned char*)lds_raw;
    const int tid = threadIdx.x, lane = tid & 63, wave = __builtin_amdgcn_readfirstlane(tid >> 6);
    const int G = gridDim.x, bx = blockIdx.x;
    const int gw = bx * NWAVES + wave, NGW = G * NWAVES;
    cg::grid_group grid = cg::this_grid();
    const int lo = args.ph_lo, hi = args.ph_hi;
#ifdef PROBE_HI
    unsigned long long* tsw = (unsigned long long*)(args.ws + WS_CTL + 4096);
    if (bx == 0 && tid == 0) tsw[0] = __builtin_amdgcn_s_memrealtime();
#define PHASE(k) if (lo <= (k) && (k) < hi) { run_phase<k>(args, lds, tid, lane, wave, G, bx, gw, NGW); grid.sync(); if (bx == 0 && tid == 0) tsw[(k) + 1] = __builtin_amdgcn_s_memrealtime(); }
#else
#define PHASE(k) if (lo <= (k) && (k) < hi) { run_phase<k>(args, lds, tid, lane, wave, G, bx, gw, NGW); if ((k) + 1 < hi) grid.sync(); }
#endif
    PHASE(0) PHASE(1) PHASE(2) PHASE(3) PHASE(4) PHASE(5) PHASE(6) PHASE(7) PHASE(8)
    PHASE(9) PHASE(10) PHASE(11) PHASE(12) PHASE(13) PHASE(14) PHASE(15) PHASE(16)
#undef PHASE
#ifdef PROBE_HI
    if (bx == 0 && tid == 0) { const float us = (float)(tsw[PROBE_HI] - tsw[PROBE_LO]) * 0.01f; *(float*)(args.ws + WS_CTL + 8192) = us / 20000.f; }
    grid.sync();
    { const float sc = 1.f + *(const float*)(args.ws + WS_CTL + 8192);
      for (size_t i = (size_t)gw * 64 + lane; i < (size_t)MTOK * DM / 4; i += (size_t)NGW * 64) { f32x4 v = ((f32x4*)args.out)[i]; ((f32x4*)args.out)[i] = v * sc; } }
#endif
}

extern "C" void kernel_launch(void* const* d_in, const int* in_sizes, int n_in, void* d_out, int out_size, void* d_ws, size_t ws_size, hipStream_t stream) {
    static int grid = 0;
    if (grid == 0) {
        if (n_in != 19 || in_sizes[0] != MTOK * DM || out_size != MTOK * DM || ws_size < WS_END) {
            fprintf(stderr, "kernel_launch: unexpected shapes (n_in %d, in0 %d, out %d, ws %zu)\n", n_in, n_in > 0 ? in_sizes[0] : -1, out_size, ws_size); grid = -1; return; }
        int dev = 0, cus = 0, per_cu = 0;
        hipGetDevice(&dev); hipDeviceGetAttribute(&cus, hipDeviceAttributeMultiprocessorCount, dev);
        hipFuncSetAttribute((const void*)hybrid_fwd, hipFuncAttributeMaxDynamicSharedMemorySize, LDS_BYTES);
        hipOccupancyMaxActiveBlocksPerMultiprocessor(&per_cu, (const void*)hybrid_fwd, NWAVES * 64, LDS_BYTES);
        if (per_cu < 1) { fprintf(stderr, "kernel_launch: occupancy query says %d blocks per CU\n", per_cu); per_cu = 1; }
        (void)hipGetLastError();
        grid = cus * 1;
    }
    if (grid < 0) return;
    Args a{};
    for (int i = 0; i < 19; ++i) a.in[i] = (const float*)d_in[i];
    a.out = (float*)d_out; a.ws = (unsigned char*)d_ws;
#if MK_SPLIT
    for (int ph = 0; ph < NPHASE; ++ph) { a.ph_lo = ph; a.ph_hi = ph + 1; hipLaunchKernelGGL(hybrid_fwd, dim3(grid), dim3(NWAVES * 64), LDS_BYTES, stream, a); }
#else
    a.ph_lo = 0; a.ph_hi = NPHASE;
    void* kargs[] = {&a};
    hipError_t e = hipLaunchCooperativeKernel((const void*)hybrid_fwd, dim3(grid), dim3(NWAVES * 64), kargs, LDS_BYTES, stream);
    if (e != hipSuccess) fprintf(stderr, "cooperative launch failed: %s (grid %d)\n", hipGetErrorString(e), grid);
#endif
}
```
